# Optimizing an MI355X kernel written in HIP

```python
import jax, jax.numpy as jnp
from jax import lax
import numpy as np

D_MODEL = 1024
BATCH = 16
SEQ = 2048
DEPTH = 1

HEAD_DIM = 64
A_HEADS = D_MODEL // (2 * HEAD_DIM)
B_HEADS = D_MODEL // (2 * HEAD_DIM)
A_WIDTH = A_HEADS * HEAD_DIM
B_WIDTH = B_HEADS * HEAD_DIM
MIX_WIDTH = A_WIDTH + B_WIDTH
IN_WIDTH = 2 * A_WIDTH + 3 * B_WIDTH
CHUNK = 128
DILATED_BRANCHES = ((128, 1), (512, 4), (2048, 16))
BAND_BLOCK = 128
ROPE_THETA = 10000.0
N_EXPERTS = 32
TOP_K = 4
D_FF = D_MODEL
SWIGLU_ALPHA = 1.702
SWIGLU_LIMIT = 7.0
NORM_EPS = 1e-5
NEG_INF = -1e30

kernel_name = "hymba_gmlp_dilated_moe_block"


def _rmsnorm(x, g):
    xf = x.astype(jnp.float32)
    y = xf * lax.rsqrt(jnp.mean(xf * xf, axis=-1, keepdims=True) + NORM_EPS)
    return (y * g.astype(jnp.float32)).astype(x.dtype)


def _rope_tables(s):
    pos = jnp.arange(s, dtype=jnp.float32)
    inv = ROPE_THETA ** (-jnp.arange(0, HEAD_DIM, 2, dtype=jnp.float32) / HEAD_DIM)
    ang = pos[:, None] * inv[None, :]
    emb = jnp.concatenate([ang, ang], axis=-1)
    return jnp.cos(emb), jnp.sin(emb)


def _apply_rope(t, cos, sin):
    tf = t.astype(jnp.float32)
    half = HEAD_DIM // 2
    rot = jnp.concatenate([-tf[..., half:], tf[..., :half]], axis=-1)
    return (tf * cos[:, None, :] + rot * sin[:, None, :]).astype(t.dtype)


def _spatial_gating(u, v, ln_g, ln_b, w_s, b_s):
    b, s, h, dh = v.shape
    u = jax.nn.gelu(u.astype(jnp.float32))
    vf = jax.nn.gelu(v.astype(jnp.float32))
    mu = jnp.mean(vf, axis=-1, keepdims=True)
    var = jnp.mean(jnp.square(vf - mu), axis=-1, keepdims=True)
    vn = (vf - mu) * lax.rsqrt(var + NORM_EPS) * ln_g.astype(jnp.float32) + ln_b.astype(jnp.float32)
    nc = s // CHUNK
    vn = vn.reshape(b, nc, CHUNK, h, dh)
    causal = jnp.tril(jnp.ones((CHUNK, CHUNK), dtype=bool))
    ws = jnp.where(causal[None], w_s.astype(jnp.float32), 0.0)
    g = jnp.einsum('hts,bnshd->bnthd', ws, vn) + b_s.astype(jnp.float32).T[:, :, None]
    return u * g.reshape(b, s, h, dh)


def _dilated_branch(q, k, v, steps, dil, scale):
    b, h, s, dh = q.shape
    L = s // dil
    nb = -(-L // BAND_BLOCK)
    Lp = nb * BAND_BLOCK

    def split(t):
        t = t.reshape(b, h, L, dil, dh).transpose(0, 1, 3, 2, 4)
        t = jnp.pad(t, ((0, 0), (0, 0), (0, 0), (0, Lp - L), (0, 0)))
        return t.reshape(b, h, dil, nb, BAND_BLOCK, dh)

    def with_prev(t):
        prev = jnp.concatenate([jnp.zeros_like(t[:, :, :, :1]), t[:, :, :, :-1]], axis=3)
        return jnp.concatenate([prev, t], axis=4)

    qb = split(q)
    kw = with_prev(split(k))
    vw = with_prev(split(v))
    sc = jnp.einsum('bhrnqd,bhrnkd->bhrnqk', qb, kw,
                    preferred_element_type=jnp.float32) * scale
    qpos = jnp.arange(BAND_BLOCK)[:, None] + BAND_BLOCK
    kpos = jnp.arange(2 * BAND_BLOCK)[None, :]
    rel = qpos - kpos
    band = (rel >= 0) & (rel <= steps)
    not_first = (jnp.arange(nb) > 0)[:, None, None]
    mask = band[None] & (not_first | (kpos >= BAND_BLOCK)[None])
    sc = jnp.where(mask, sc, NEG_INF)
    m = jnp.max(sc, axis=-1, keepdims=True)
    p = jnp.exp(sc - m)
    l = jnp.sum(p, axis=-1, keepdims=True)
    o = jnp.einsum('bhrnqk,bhrnkd->bhrnqd', p, vw.astype(jnp.float32)) / l
    lse = (m + jnp.log(l))[..., 0]
    o = o.reshape(b, h, dil, Lp, dh)[:, :, :, :L].transpose(0, 1, 3, 2, 4).reshape(b, h, s, dh)
    lse = lse.reshape(b, h, dil, Lp)[..., :L].transpose(0, 1, 3, 2).reshape(b, h, s)
    return o, lse


def _dilated_mixture(q, k, v):
    scale = HEAD_DIM ** -0.5
    outs, lses = [], []
    for window, dil in DILATED_BRANCHES:
        o, lse = _dilated_branch(q, k, v, window // dil, dil, scale)
        outs.append(o)
        lses.append(lse)
    w = jax.nn.softmax(jnp.stack(lses), axis=0)
    return jnp.einsum('nbhs,nbhsd->bhsd', w, jnp.stack(outs))


def _moe(xn, w_router, b_router, w_gate_up, b_gate_up, w_down, b_down):
    b, s, d = xn.shape
    xf = xn.reshape(-1, d)
    t = xf.shape[0]
    logits = jnp.dot(xf, w_router, preferred_element_type=jnp.float32) + b_router.astype(jnp.float32)
    top_val, top_idx = lax.top_k(logits, TOP_K)
    gates = jax.nn.softmax(top_val, axis=-1)
    flat_e = top_idx.reshape(-1)
    order = jnp.argsort(flat_e)
    e_sorted = flat_e[order]
    tok = order // TOP_K
    gate_sorted = gates.reshape(-1)[order]
    group_sizes = jnp.bincount(flat_e, length=N_EXPERTS).astype(jnp.int32)
    xs = xf[tok]
    hgu = lax.ragged_dot(xs, w_gate_up, group_sizes) + b_gate_up[e_sorted]
    gate = jnp.minimum(hgu[:, :D_FF], SWIGLU_LIMIT)
    up = jnp.clip(hgu[:, D_FF:], -SWIGLU_LIMIT, SWIGLU_LIMIT)
    act = (up + 1) * (gate * jax.nn.sigmoid(gate * SWIGLU_ALPHA))
    y = lax.ragged_dot(act, w_down, group_sizes) + b_down[e_sorted]
    y = y * gate_sorted[:, None].astype(y.dtype)
    out = jnp.zeros((t, d), y.dtype).at[tok].add(y)
    return out.reshape(b, s, d).astype(xn.dtype)


def setup_inputs(seed: int = 0) -> dict:
    key = jax.random.key(seed)
    ks = jax.random.split(key, 20)
    f32 = jnp.float32
    n = lambda k, shape, sc: jax.random.normal(k, shape, f32) * sc
    return {
        "x": jax.random.normal(ks[0], (BATCH, SEQ, D_MODEL), f32),
        "norm1_g": 1.0 + n(ks[1], (DEPTH, D_MODEL), 0.02),
        "w_in": n(ks[2], (DEPTH, D_MODEL, IN_WIDTH), D_MODEL ** -0.5),
        "a_ln_g": 1.0 + n(ks[3], (DEPTH, A_HEADS, HEAD_DIM), 0.02),
        "a_ln_b": n(ks[4], (DEPTH, A_HEADS, HEAD_DIM), 0.02),
        "a_w_s": n(ks[5], (DEPTH, A_HEADS, CHUNK, CHUNK), CHUNK ** -0.5),
        "a_b_s": 1.0 + n(ks[6], (DEPTH, A_HEADS, CHUNK), 0.02),
        "a_out_g": 1.0 + n(ks[7], (DEPTH, A_WIDTH), 0.02),
        "b_out_g": 1.0 + n(ks[8], (DEPTH, B_WIDTH), 0.02),
        "w_out": n(ks[9], (DEPTH, MIX_WIDTH, D_MODEL), MIX_WIDTH ** -0.5),
        "norm2_g": 1.0 + n(ks[10], (DEPTH, D_MODEL), 0.02),
        "w_router": n(ks[11], (DEPTH, D_MODEL, N_EXPERTS), D_MODEL ** -0.5),
        "b_router": n(ks[12], (DEPTH, N_EXPERTS), 0.01),
        "w_gate_up": n(ks[13], (DEPTH, N_EXPERTS, D_MODEL, 2 * D_FF), D_MODEL ** -0.5),
        "b_gate_up": n(ks[14], (DEPTH, N_EXPERTS, 2 * D_FF), 0.01),
        "w_down": n(ks[15], (DEPTH, N_EXPERTS, D_FF, D_MODEL), D_FF ** -0.5),
        "b_down": n(ks[16], (DEPTH, N_EXPERTS, D_MODEL), 0.01),
        "normf_g": 1.0 + n(ks[17], (D_MODEL,), 0.02),
    }


def reference(x, norm1_g, w_in, a_ln_g, a_ln_b, a_w_s, a_b_s, a_out_g, b_out_g, w_out,
              norm2_g, w_router, b_router, w_gate_up, b_gate_up, w_down, b_down, normf_g):
    b, s, _ = x.shape
    cos, sin = _rope_tables(s)
    cuts = [A_WIDTH, 2 * A_WIDTH, 2 * A_WIDTH + B_WIDTH, 2 * A_WIDTH + 2 * B_WIDTH]
    h = x
    for layer in range(DEPTH):
        xn = _rmsnorm(h, norm1_g[layer])
        proj = jnp.einsum('bsd,de->bse', xn, w_in[layer])
        a_u, a_v, q, k, v = jnp.split(proj, cuts, axis=-1)
        a_out = _spatial_gating(a_u.reshape(b, s, A_HEADS, HEAD_DIM),
                                a_v.reshape(b, s, A_HEADS, HEAD_DIM),
                                a_ln_g[layer], a_ln_b[layer], a_w_s[layer], a_b_s[layer])
        a_out = _rmsnorm(a_out.reshape(b, s, A_WIDTH), a_out_g[layer])
        q = _apply_rope(q.reshape(b, s, B_HEADS, HEAD_DIM), cos, sin).transpose(0, 2, 1, 3)
        k = _apply_rope(k.reshape(b, s, B_HEADS, HEAD_DIM), cos, sin).transpose(0, 2, 1, 3)
        v = v.reshape(b, s, B_HEADS, HEAD_DIM).transpose(0, 2, 1, 3)
        b_out = _dilated_mixture(q, k, v).transpose(0, 2, 1, 3).reshape(b, s, B_WIDTH)
        b_out = _rmsnorm(b_out, b_out_g[layer])
        mixed = jnp.concatenate([a_out, b_out], axis=-1).astype(h.dtype)
        h = h + jnp.einsum('bse,ed->bsd', mixed, w_out[layer])
        hn = _rmsnorm(h, norm2_g[layer])
        h = h + _moe(hn, w_router[layer], b_router[layer], w_gate_up[layer],
                     b_gate_up[layer], w_down[layer], b_down[layer])
    return _rmsnorm(h, normf_g)
```

```cpp
#include <hip/hip_runtime.h>
#include <cstdio>
#include <cstdint>

#define LAS __attribute__((address_space(3)))
#define GAS __attribute__((address_space(1)))
typedef unsigned short bf16_t;
typedef short bf16x8 __attribute__((ext_vector_type(8)));
typedef short s16x4 __attribute__((ext_vector_type(4)));
typedef float f32x2 __attribute__((ext_vector_type(2)));
typedef float f32x4 __attribute__((ext_vector_type(4)));
typedef float f32x16 __attribute__((ext_vector_type(16)));
typedef unsigned u32x2 __attribute__((ext_vector_type(2)));
typedef unsigned u32x4 __attribute__((ext_vector_type(4)));
typedef GAS unsigned gu32;
typedef int v8i __attribute__((ext_vector_type(8)));

constexpr int BATCH = 16, SEQ = 2048, DM = 1024, T = BATCH * SEQ, HD = 64, NH = 8, AW = 512, INW = 2560;
constexpr int NE = 32, TOPK = 4, DFF = 1024, CHUNK = 128;
constexpr float NORM_EPS = 1e-5f;
constexpr float QSCALE = 0.125f * 1.4426950408889634f;

constexpr size_t MiB = 1u << 20, KiB = 1u << 10;
constexpr size_t WS_CTL = 0, CTL_ZERO_BYTES = 64 * KiB;
constexpr size_t WS_WRT = 1 * MiB, WS_WSB = 1 * MiB + 256 * KiB, WS_COS = 2 * MiB, WS_SIN = 2 * MiB + 256 * KiB;
constexpr size_t WS_R1 = 3 * MiB, WS_R2 = 3 * MiB + 128 * KiB, WS_LSE = 8 * MiB;
constexpr size_t WS_WIN = 16 * MiB, WS_WOUT = 22 * MiB, WS_WGU = 24 * MiB, WS_WD = 152 * MiB, WS_H = 216 * MiB, WS_HB = 344 * MiB;
constexpr size_t WS_ACT = 408 * MiB, WS_XB = 408 * MiB, WS_U = 472 * MiB, WS_VN = 504 * MiB, WS_Q = 536 * MiB, WS_K = 568 * MiB, WS_V = 600 * MiB;
constexpr size_t WS_CONTRIB = 680 * MiB, WS_MIXED = 680 * MiB, WS_BPART = 744 * MiB, WS_LISTR = 936 * MiB, WS_LISTG = 944 * MiB, WS_END = 953 * MiB;
constexpr int CW_TMO = 0, CW_CNT = 8192, CW_BAR = 4096;

constexpr int RING_OFF = 0, RING_BYTES = 131072;
constexpr int LDSCTL_OFF = RING_BYTES;
constexpr int TS_OFF = LDSCTL_OFF, CNT_OFF = LDSCTL_OFF + 256, MISC_OFF = LDSCTL_OFF + 512, HIST_OFF = LDSCTL_OFF + 640, EXCH_OFF = LDSCTL_OFF + 1024, META_OFF = LDSCTL_OFF + 5120;
constexpr int OST_OFF = META_OFF + 6144;
constexpr int GTAB_OFF = OST_OFF + 16384;
constexpr int LDS_BYTES = 163840;
static_assert(EXCH_OFF + 4096 <= META_OFF && GTAB_OFF + 4608 <= LDS_BYTES && 8 * 2816 <= 6144 + 16384, "LDS map");

#define LDS_WAIT() asm volatile("s_waitcnt lgkmcnt(0)" ::: "memory")
#define VM_WAIT() asm volatile("s_waitcnt vmcnt(0)" ::: "memory")
#define RLX_AGENT __ATOMIC_RELAXED, __HIP_MEMORY_SCOPE_AGENT

__device__ __forceinline__ unsigned cvt_pk_bf16(float lo, float hi) { unsigned r; asm volatile("v_cvt_pk_bf16_f32 %0, %1, %2" : "=v"(r) : "v"(lo), "v"(hi)); return r; }
__device__ __forceinline__ unsigned pk4_fp8(float a, float b, float c, float d) { unsigned w = 0; w = __builtin_amdgcn_cvt_pk_fp8_f32(a, b, w, false); w = __builtin_amdgcn_cvt_pk_fp8_f32(c, d, w, true); return w; }
__device__ __forceinline__ float bf_lo(unsigned w) { return __uint_as_float(w << 16); }
__device__ __forceinline__ float bf_hi(unsigned w) { return __uint_as_float(w & 0xffff0000u); }
__device__ __forceinline__ float wave_sum(float v) {
#pragma unroll
    for (int o = 1; o < 64; o <<= 1) v += __shfl_xor(v, o);
    return v;
}
__device__ __forceinline__ float gelu_tanh(float x) {
    const float u = x * (1.0f + 0.044715f * x * x);
    const float e = __builtin_amdgcn_exp2f(-2.3022081981f * u);
    return x * __builtin_amdgcn_rcpf(1.0f + e);
}

__device__ __forceinline__ int fresh_tid() { int t = threadIdx.x; asm volatile("" : "+v"(t)); return t; }
#define XB_TMO      128
#define XB_XCNT(j)  (256  + 64 * (j))
#define XB_XSUB(j)  (1280 + 64 * (j))
#define XB_XGEN(j)  (2304 + 64 * (j))
#define XB_TOP      3328
#define XB_TOPGEN   3392
#define XCD_BAR_WORDS 3456
#define XB_SPIN_CAP (1u << 18)
__device__ __forceinline__ unsigned xb_ld(unsigned* p)              { return __hip_atomic_load(p, __ATOMIC_RELAXED, __HIP_MEMORY_SCOPE_AGENT); }
__device__ __forceinline__ unsigned xb_add(unsigned* p, unsigned v) { return __hip_atomic_fetch_add(p, v, __ATOMIC_RELAXED, __HIP_MEMORY_SCOPE_AGENT); }
__device__ __forceinline__ unsigned xb_xcc_id() { return (unsigned)__builtin_amdgcn_s_getreg((3 << 11) | 20) & 0xFu; }
#define XB_SPIN(cond, bar) do { unsigned _sp = 0; while (cond) { __builtin_amdgcn_s_sleep(1); \
    if ((++_sp & 255u) == 0u) { if (xb_ld(&(bar)[XB_TMO])) break; if (_sp > XB_SPIN_CAP) { atomicAdd(&(bar)[XB_TMO], 1u); break; } } } } while (0)
struct XcdBarrier { unsigned* bar; unsigned x; volatile LAS unsigned* st; };
__device__ __forceinline__ XcdBarrier xcd_barrier_post(unsigned* bar, volatile LAS unsigned* st) {
    XcdBarrier b; b.bar = bar; b.x = xb_xcc_id(); b.st = st;
    if (threadIdx.x == 0) (void)xb_add(&bar[XB_XCNT(b.x)], 1u);
    return b;
}
__device__ __forceinline__ void xcd_barrier_complete(unsigned* bar, unsigned x, unsigned& nloc, unsigned& nx) {
    const unsigned G = gridDim.x * gridDim.y * gridDim.z;
    unsigned sum, cnt, mine, sp = 0u;
    for (;;) {
        sum = 0u; cnt = 0u; mine = 0u;
#pragma unroll
        for (unsigned j = 0; j < 16; ++j) { const unsigned c = xb_ld(&bar[XB_XCNT(j)]); sum += c; cnt += (c > 0u) ? 1u : 0u; mine = (j == x) ? c : mine; }
        if (sum == G) break;
        __builtin_amdgcn_s_sleep(1);
        if ((++sp & 255u) == 0u) { if (xb_ld(&bar[XB_TMO])) break; if (sp > XB_SPIN_CAP) { atomicAdd(&bar[XB_TMO], 1u); break; } }
    }
    nloc = mine > 0u ? mine : 1u; nx = cnt > 0u ? cnt : 1u;
}
__device__ __forceinline__ void xcd_barrier(const XcdBarrier& b) {
    asm volatile("s_waitcnt vmcnt(0)" ::: "memory");
    __syncthreads();
    if (threadIdx.x == 0) {
        unsigned* bar = b.bar;
        const unsigned bx = xb_xcc_id();
        __builtin_amdgcn_s_waitcnt(0);
        unsigned nloc = b.st[0], nx = b.st[1];
        if (nloc == 0u) { xcd_barrier_complete(bar, bx, nloc, nx); b.st[0] = nloc; b.st[1] = nx; }
        const unsigned old = xb_add(&bar[XB_XSUB(bx)], 1u);
        const unsigned gen = old / nloc;
        if (old + 1u == (gen + 1u) * nloc) {
            __builtin_amdgcn_fence(__ATOMIC_RELEASE, "agent");
            asm volatile("s_waitcnt vmcnt(0)" ::: "memory");
            const unsigned og = xb_add(&bar[XB_TOP], 1u);
            const unsigned tg = og / nx;
            if (og + 1u == (tg + 1u) * nx) xb_add(&bar[XB_TOPGEN], 1u);
            else XB_SPIN(xb_ld(&bar[XB_TOPGEN]) == tg, bar);
            __builtin_amdgcn_fence(__ATOMIC_ACQUIRE, "agent");
            xb_add(&bar[XB_XGEN(bx)], 1u);
            asm volatile("s_waitcnt vmcnt(0)" ::: "memory");
        } else {
            XB_SPIN(xb_ld(&bar[XB_XGEN(bx)]) == gen, bar);
            __builtin_amdgcn_fence(__ATOMIC_ACQUIRE, "agent");
            asm volatile("s_waitcnt vmcnt(0)" ::: "memory");
        }
    }
    __syncthreads();
}

__device__ __forceinline__ size_t kv_off(int b, int head, int t) { return ((size_t)((b * NH + head) * SEQ + ((t & 15) << 7) + (t >> 4))) * HD; }
namespace pg8 {
constexpr int BM = 256, BK = 64, HALF = 128, HTB = HALF * BK * 2, NXCD = 8, WGM = 8, KD = 1024;
__device__ __forceinline__ int lds_byte(int r, int c) { const int st = (r >> 4) * 2 + (c >> 5), rr = r & 15, cc = c & 31, ob = rr * 64 + cc * 2; return st * 1024 + (ob ^ (((ob >> 9) & 1) << 5)); }
__device__ __forceinline__ void stage_rc(int b, int& R, int& C) { const int st = b / 1024, sb = b % 1024, swz = sb ^ (((sb >> 9) & 1) << 5); R = (st >> 1) * 16 + swz / 64; C = (st & 1) * 32 + (swz % 64) / 2; }
__device__ __forceinline__ int perm32(int rho) { const int n = rho >> 4, i = rho & 15; return 8 * (i >> 2) + 4 * n + (i & 3); }

struct Unit { int pm, pn, e, lrow0, nvalid; };
typedef int v4i __attribute__((ext_vector_type(4)));
__device__ __forceinline__ v8i ld_frag(const LAS unsigned char* p) { const v4i lo = *(const LAS v4i*)p, hi = *(const LAS v4i*)(p + 1024); return __builtin_shufflevector(lo, hi, 0, 1, 2, 3, 4, 5, 6, 7); }
__device__ __forceinline__ bf16x8 frag_k(const v8i f, int k) { const v4i h = k ? __builtin_shufflevector(f, f, 4, 5, 6, 7) : __builtin_shufflevector(f, f, 0, 1, 2, 3); return __builtin_bit_cast(bf16x8, h); }

__device__ __forceinline__ bool tile_of(int L, int nM, int nN, int& pm, int& pn, const int WGM = 8) {
    const int nwg = nM * nN; if (L >= nwg) return false;
    int wgid = L; { const int q = nwg / NXCD, r = nwg % NXCD, xcd = wgid % NXCD, off = wgid / NXCD; wgid = (xcd < r ? xcd * (q + 1) : r * (q + 1) + (xcd - r) * q) + off; }
    const int nig = WGM * nN, gid = wgid / nig, fm = gid * WGM, gsz = (nM - fm) < WGM ? (nM - fm) : WGM;
    pm = fm + ((wgid % nig) % gsz); pn = (wgid % nig) / gsz; return true;
}
struct DenseSched {
    static constexpr bool HAS_META = false; static constexpr int RB = KD * 2, BMAP = 0, RBB = RB, KSB = BK * 2, KSA = BK * 2;
    const char* A; const char* Bt; int nM, nN, G, c;
    __device__ __forceinline__ const char* meta_src(const Unit&) const { return nullptr; }
    __device__ __forceinline__ void a_offs_meta(const Unit& u, const LAS unsigned char*, const int (&R)[2], const int (&C)[2], unsigned (&o)[2][2]) const { a_offs(u, R, C, o); }
    __device__ __forceinline__ bool next(int i, Unit& u) const { u.e = 0; u.lrow0 = 0; u.nvalid = 256; return tile_of(i * G + c, nM, nN, u.pm, u.pn); }
    __device__ __forceinline__ const char* a_base() const { return A; }
    __device__ __forceinline__ void a_offs(const Unit& u, const int (&R)[2], const int (&C)[2], unsigned (&o)[2][2]) const {
#pragma unroll
        for (int h = 0; h < 2; ++h)
#pragma unroll
            for (int i = 0; i < 2; ++i) o[h][i] = (unsigned)((u.pm * BM + h * HALF + R[i]) * KD + C[i]) * 2u;
    }
    __device__ __forceinline__ const char* b_tile(const Unit& u) const { return Bt + (size_t)u.pn * (BM * KD * 2); }
};
template <bool GATHER>
struct MoeSched {
    static constexpr bool HAS_META = true; static constexpr int RB = KD, BMAP = GATHER ? 0 : 1, RBB = 128, KSB = 256 * 128, KSA = GATHER ? BK * 2 : 256 * 128;
    const char* A; const char* Bt; const u32x2* list; LAS const int* ts; LAS const int* cnt; int nN, nM, G, c;
    __device__ __forceinline__ bool next(int i, Unit& u) const {
        if (!tile_of(i * G + c, nM, nN, u.pm, u.pn, GATHER ? 4 : 8)) return false;
        int e = 0;
#pragma unroll
        for (int s = 16; s >= 1; s >>= 1) { const int v = __builtin_amdgcn_readfirstlane(ts[e + s]); if (v <= u.pm) e += s; }
        const int t0 = __builtin_amdgcn_readfirstlane(ts[e]), ce = __builtin_amdgcn_readfirstlane(cnt[e]);
        u.e = e; u.lrow0 = (u.pm - t0) * BM; const int rem = ce - u.lrow0; u.nvalid = rem < BM ? rem : BM; return true;
    }
    __device__ __forceinline__ const char* a_base() const { return A; }
    __device__ __forceinline__ const char* meta_src(const Unit& u) const { return (const char*)(list + (size_t)u.e * T + u.lrow0); }
    __device__ __forceinline__ void a_offs(const Unit& u, const int (&R)[2], const int (&C)[2], unsigned (&o)[2][2]) const {
#pragma unroll
        for (int h = 0; h < 2; ++h)
#pragma unroll
            for (int i = 0; i < 2; ++i) {
                if (GATHER) { int lr = h * HALF + R[i]; lr = lr < u.nvalid ? lr : 0; const unsigned v = list[(size_t)u.e * T + u.lrow0 + lr].x; o[h][i] = (unsigned)((int)(v >> 2) * RB + C[i] * 2); }
                else o[h][i] = (unsigned)(u.pm * (8 * 32768) + (h * HALF + R[i]) * 128 + C[i] * 2);
            }
    }
    __device__ __forceinline__ void a_offs_meta(const Unit& u, const LAS unsigned char* meta, const int (&R)[2], const int (&C)[2], unsigned (&o)[2][2]) const {
#pragma unroll
        for (int h = 0; h < 2; ++h)
#pragma unroll
            for (int i = 0; i < 2; ++i) {
                if (GATHER) { int lr = h * HALF + R[i]; lr = lr < u.nvalid ? lr : 0; const unsigned v = *(const LAS unsigned*)(meta + lr * 8); o[h][i] = (unsigned)((int)(v >> 2) * RB + C[i] * 2); }
                else o[h][i] = (unsigned)(u.pm * (8 * 32768) + (h * HALF + R[i]) * 128 + C[i] * 2);
            }
    }
    __device__ __forceinline__ const char* b_tile(const Unit& u) const { return Bt + ((size_t)u.e * nN + u.pn) * (size_t)(BM * RB); }
};

template <class Epi, class Sched>
__device__ __forceinline__ void gemm_phase(LAS unsigned char* lds, const Sched& S, const Epi& E) {
    constexpr int RB = Sched::RB, nt = RB / (BK * 2);
    constexpr bool F8 = (RB == KD);
    const int tid = fresh_tid(), wid = __builtin_amdgcn_readfirstlane(tid >> 6), lane = tid & 63, wr = wid >> 2, wc = wid & 3, fr = lane & 15, fq = lane >> 4;
    int R[2], C[2]; unsigned voffB[2];
#pragma unroll
    for (int i = 0; i < 2; ++i) { stage_rc(tid * 16 + i * 8192, R[i], C[i]); const int rho = R[i] & 31;
        const int Rb = Sched::BMAP == 0 ? (R[i] & ~31) + perm32(rho) : 64 * (R[i] >> 5) + 16 * ((rho & 15) >> 2) + 4 * (rho >> 4) + (rho & 3);
        voffB[i] = (unsigned)(Rb * Sched::RBB + C[i] * 2); }
    constexpr size_t kstep = (size_t)Sched::KSA, kstepB = (size_t)Sched::KSB;
    constexpr size_t hstepB = (size_t)(Sched::BMAP == 0 ? HALF : 8) * Sched::RBB;
    const unsigned ldsw = (unsigned)wid * 1024u;
    const int aoff = lds_byte(wr * 64 + fr, fq * 8), boff = lds_byte(wc * 32 + fr, fq * 8);
#define PG8_SA(b, h) (((b) * 2 + (h)) * HTB)
#define PG8_SB(b, h) ((4 + (b) * 2 + (h)) * HTB)
#define PG8_STAGE_B(bufoff, gbase) do { _Pragma("unroll") for (int _i = 0; _i < 2; ++_i) \
        __builtin_amdgcn_global_load_lds((const unsigned*)((const char*)(gbase) + voffB[_i]), (LAS unsigned*)(lds + (bufoff) + ldsw + _i * 8192), 16, 0, 0); } while (0)
#define PG8_STAGE_A(bufoff, kb, off, h) do { _Pragma("unroll") for (int _i = 0; _i < 2; ++_i) \
        __builtin_amdgcn_global_load_lds((const unsigned*)(Ab + (kb) + (off)[h][_i]), (LAS unsigned*)(lds + (bufoff) + ldsw + _i * 8192), 16, 0, 0); } while (0)
#define PG8_LDA(dst, b, h) do { _Pragma("unroll") for (int m = 0; m < 4; ++m) dst[m] = ld_frag(lds + PG8_SA(b, h) + aoff + m * 2048); } while (0)
#define PG8_LDB(dst, b, h) do { _Pragma("unroll") for (int n = 0; n < 2; ++n) dst[n] = ld_frag(lds + PG8_SB(b, h) + boff + n * 2048); } while (0)
#define PG8_MMA(ai, bj, At, Bt) do { __builtin_amdgcn_s_setprio(1); _Pragma("unroll") for (int m = 0; m < 4; ++m) _Pragma("unroll") for (int n = 0; n < 2; ++n) { \
        if constexpr (F8) { acc[ai][bj][m][n] = __builtin_amdgcn_mfma_scale_f32_16x16x128_f8f6f4(Bt[n], At[m], acc[ai][bj][m][n], 0, 0, 0, 0x7F7F7F7F, 0, 0x7F7F7F7F); } \
        else { _Pragma("unroll") for (int k = 0; k < 2; ++k) acc[ai][bj][m][n] = __builtin_amdgcn_mfma_f32_16x16x32_bf16(frag_k(Bt[n], k), frag_k(At[m], k), acc[ai][bj][m][n], 0, 0, 0); } } \
        __builtin_amdgcn_s_setprio(0); } while (0)
#define PG8_META(slot) (lds + (META_OFF - RING_OFF) + (slot) * 2048)
#define PG8_META_DMA(slot, src) do { if (Sched::HAS_META && wid == 0) { _Pragma("unroll") for (int _i = 0; _i < 2; ++_i) \
        __builtin_amdgcn_global_load_lds((const unsigned*)((const char*)(src) + (unsigned)((fresh_tid() & 63) * 16 + _i * 1024)), (LAS unsigned*)(PG8_META(slot) + _i * 1024), 16, 0, 0); } } while (0)
#define PG8_WAIT_V(n) asm volatile("s_waitcnt vmcnt(" #n ")" ::: "memory")
#define PG8_WAIT_L(n) asm volatile("s_waitcnt lgkmcnt(" #n ")" ::: "memory")
#define PG8_BAR __builtin_amdgcn_s_barrier()
#define PG8_SCHED __builtin_amdgcn_sched_barrier(0)
    Unit cur, nxt; int ui = 0, sc = 0;
    if (!S.next(0, cur)) return;
    f32x4 acc[2][2][4][2];
#pragma unroll
    for (int a = 0; a < 2; ++a)
#pragma unroll
        for (int b = 0; b < 2; ++b)
#pragma unroll
            for (int m = 0; m < 4; ++m)
#pragma unroll
                for (int n = 0; n < 2; ++n) acc[a][b][m][n] = (f32x4){0.f, 0.f, 0.f, 0.f};
    v8i At[4], B0[2], B1[2];
    unsigned co[2][2];
    S.a_offs(cur, R, C, co);
    const char* const Ab = S.a_base();
    const char* cB = S.b_tile(cur);
    PG8_META_DMA(0, S.meta_src(cur));
    PG8_STAGE_B(PG8_SB(0, 0), cB); PG8_STAGE_B(PG8_SB(0, 1), cB + hstepB); PG8_STAGE_A(PG8_SA(0, 0), 0, co, 0); PG8_STAGE_A(PG8_SA(0, 1), 0, co, 1);
    if (wr == 1) PG8_BAR;
    PG8_WAIT_V(2); PG8_BAR;
    PG8_STAGE_B(PG8_SB(1, 0), cB + kstepB); PG8_STAGE_A(PG8_SA(1, 0), kstep, co, 0); PG8_STAGE_B(PG8_SB(1, 1), cB + hstepB + kstepB);
    PG8_WAIT_V(6); PG8_BAR;
    for (;;) {
        const bool has_next = S.next(ui + 1, nxt);
        const char* nB = cB;
        const int sn = (sc == 2) ? 0 : sc + 1;
        if (has_next) { nB = S.b_tile(nxt); PG8_META_DMA(sn, S.meta_src(nxt)); }
#pragma nounroll
        for (int t = 0; t < nt; t += 2) {
            const bool last = (t == nt - 2);
            const size_t k1 = (size_t)(t + 1) * kstep;
            const size_t k2 = last ? (size_t)0 : (size_t)(t + 2) * kstep; const char* b2 = last ? nB : cB + (size_t)(t + 2) * kstepB;
            const size_t k3 = k2 + kstep; const char* b3 = b2 + kstepB;
            PG8_LDB(B0, 0, 0); PG8_LDB(B1, 0, 1); PG8_SCHED; PG8_LDA(At, 0, 0); PG8_STAGE_A(PG8_SA(1, 1), k1, co, 1);
            PG8_WAIT_V(8); PG8_WAIT_L(0); PG8_BAR; PG8_MMA(0, 0, At, B0); PG8_MMA(0, 1, At, B1); PG8_BAR; PG8_SCHED;
            if (last && has_next) {
                int R2[2], C2[2]; const int t2 = fresh_tid();
#pragma unroll
                for (int i = 0; i < 2; ++i) stage_rc(t2 * 16 + i * 8192, R2[i], C2[i]);
                S.a_offs_meta(nxt, PG8_META(sn), R2, C2, co);
            }
            PG8_LDA(At, 0, 1); PG8_STAGE_B(PG8_SB(0, 0), b2); PG8_STAGE_B(PG8_SB(0, 1), b2 + hstepB); PG8_STAGE_A(PG8_SA(0, 0), k2, co, 0);
            PG8_WAIT_V(8); PG8_WAIT_L(0); PG8_BAR; PG8_MMA(1, 0, At, B0); PG8_MMA(1, 1, At, B1); PG8_BAR; PG8_SCHED;
            PG8_LDB(B0, 1, 0); PG8_LDB(B1, 1, 1); PG8_SCHED; PG8_LDA(At, 1, 0); PG8_STAGE_A(PG8_SA(0, 1), k2, co, 1);
            PG8_WAIT_V(8); PG8_WAIT_L(0); PG8_BAR; PG8_MMA(0, 0, At, B0); PG8_MMA(0, 1, At, B1); PG8_BAR; PG8_SCHED;
            PG8_LDA(At, 1, 1); PG8_STAGE_B(PG8_SB(1, 0), b3); PG8_STAGE_B(PG8_SB(1, 1), b3 + hstepB); PG8_STAGE_A(PG8_SA(1, 0), k3, co, 0);
            PG8_WAIT_V(8); PG8_WAIT_L(0); PG8_BAR; PG8_MMA(1, 0, At, B0); PG8_MMA(1, 1, At, B1); PG8_BAR; PG8_SCHED;
        }
        if (wr == 0) PG8_BAR;
        E(acc, cur, wr, wc, fr, fq, PG8_META(sc));
        if (!has_next) break;
#pragma unroll
        for (int a = 0; a < 2; ++a)
#pragma unroll
            for (int b = 0; b < 2; ++b)
#pragma unroll
                for (int m = 0; m < 4; ++m)
#pragma unroll
                    for (int n = 0; n < 2; ++n) acc[a][b][m][n] = (f32x4){0.f, 0.f, 0.f, 0.f};
        cur = nxt; cB = nB; ++ui; sc = sn;
        if (wr == 1) PG8_BAR;
    }
    PG8_WAIT_V(0);
    PG8_BAR;
#undef PG8_SA
#undef PG8_SB
#undef PG8_STAGE_A
#undef PG8_STAGE_B
#undef PG8_META
#undef PG8_META_DMA
#undef PG8_LDA
#undef PG8_LDB
#undef PG8_MMA
#undef PG8_WAIT_V
#undef PG8_WAIT_L
#undef PG8_BAR
#undef PG8_SCHED
}

__device__ __forceinline__ void store_bf16x8(bf16_t* p, const f32x4 a, const f32x4 b) {
    u32x4 w; w.x = cvt_pk_bf16(a[0], a[1]); w.y = cvt_pk_bf16(a[2], a[3]); w.z = cvt_pk_bf16(b[0], b[1]); w.w = cvt_pk_bf16(b[2], b[3]);
    *(u32x4*)p = w;
}

struct EpiProj {
    bf16_t *U, *VN, *Q, *KK, *V; const float *R1, *cosT, *sinT, *lng, *lnb;
    __device__ __forceinline__ void operator()(const f32x4 (&acc)[2][2][4][2], const Unit& u, int wr, int wc, int fr, int fq, const LAS unsigned char* meta) const {
        const int type = u.pn >> 1, head = (u.pn & 1) * 4 + wc, colb = head * HD + 8 * fq;
        const int row0 = u.pm * BM + wr * 64 + fr;
        float rsv[8];
#pragma unroll
        for (int k = 0; k < 8; ++k) rsv[k] = R1[row0 + (k >> 2) * HALF + (k & 3) * 16];
        if (type == 0 || type == 4) {
            bf16_t* const dst = type == 0 ? U : V;
#pragma unroll
            for (int k = 0; k < 8; ++k) { const int ai = k >> 2, m = k & 3; const float rs = rsv[k];
                f32x4 x00 = acc[ai][0][m][0] * rs, x01 = acc[ai][0][m][1] * rs, x10 = acc[ai][1][m][0] * rs, x11 = acc[ai][1][m][1] * rs;
                if (type == 0) {
#pragma unroll
                    for (int j = 0; j < 4; ++j) { x00[j] = gelu_tanh(x00[j]); x01[j] = gelu_tanh(x01[j]); x10[j] = gelu_tanh(x10[j]); x11[j] = gelu_tanh(x11[j]); } }
                const int row = row0 + ai * HALF + m * 16;
                bf16_t* rp = type == 0 ? dst + (size_t)row * AW + colb : dst + kv_off(row >> 11, head, row & (SEQ - 1)) + 8 * fq;
                store_bf16x8(rp, x00, x01); store_bf16x8(rp + 32, x10, x11); }
        } else if (type == 1) {
            const float* gp = lng + colb; const float* bp = lnb + colb;
            const f32x4 lg0 = *(const f32x4*)(gp), lg1 = *(const f32x4*)(gp + 4), lg2 = *(const f32x4*)(gp + 32), lg3 = *(const f32x4*)(gp + 36);
            const f32x4 lb0 = *(const f32x4*)(bp), lb1 = *(const f32x4*)(bp + 4), lb2 = *(const f32x4*)(bp + 32), lb3 = *(const f32x4*)(bp + 36);
#pragma unroll
            for (int k = 0; k < 8; ++k) { const int ai = k >> 2, m = k & 3; const float rs = rsv[k];
                f32x4 x00 = acc[ai][0][m][0] * rs, x01 = acc[ai][0][m][1] * rs, x10 = acc[ai][1][m][0] * rs, x11 = acc[ai][1][m][1] * rs;
#pragma unroll
                for (int j = 0; j < 4; ++j) { x00[j] = gelu_tanh(x00[j]); x01[j] = gelu_tanh(x01[j]); x10[j] = gelu_tanh(x10[j]); x11[j] = gelu_tanh(x11[j]); }
                float sm = 0.f;
#pragma unroll
                for (int j = 0; j < 4; ++j) sm += (x00[j] + x01[j]) + (x10[j] + x11[j]);
                sm += __shfl_xor(sm, 16); sm += __shfl_xor(sm, 32);
                const float mu = sm * (1.0f / 64.0f);
                x00 -= mu; x01 -= mu; x10 -= mu; x11 -= mu;
                float q = 0.f;
#pragma unroll
                for (int j = 0; j < 4; ++j) q += (x00[j] * x00[j] + x01[j] * x01[j]) + (x10[j] * x10[j] + x11[j] * x11[j]);
                q += __shfl_xor(q, 16); q += __shfl_xor(q, 32);
                const float rstd = 1.0f / sqrtf(q * (1.0f / 64.0f) + NORM_EPS);
                x00 = x00 * rstd * lg0 + lb0; x01 = x01 * rstd * lg1 + lb1; x10 = x10 * rstd * lg2 + lb2; x11 = x11 * rstd * lg3 + lb3;
                bf16_t* rp = VN + (size_t)(row0 + ai * HALF + m * 16) * AW + colb;
                store_bf16x8(rp, x00, x01); store_bf16x8(rp + 32, x10, x11); }
        } else {
            bf16_t* const dst = type == 2 ? Q : KK; const float sc = type == 2 ? QSCALE : 1.0f;
#pragma unroll
            for (int kp = 0; kp < 4; ++kp) {
                f32x4 tc0[2], tc1[2], ts0[2], ts1[2];
#pragma unroll
                for (int mm = 0; mm < 2; ++mm) { const int k = 2 * kp + mm, pos = (row0 + (k >> 2) * HALF + (k & 3) * 16) & (SEQ - 1);
                    tc0[mm] = *(const f32x4*)(cosT + pos * 32 + 8 * fq); tc1[mm] = *(const f32x4*)(cosT + pos * 32 + 8 * fq + 4); ts0[mm] = *(const f32x4*)(sinT + pos * 32 + 8 * fq); ts1[mm] = *(const f32x4*)(sinT + pos * 32 + 8 * fq + 4); }
#pragma unroll
                for (int mm = 0; mm < 2; ++mm) { const int k = 2 * kp + mm, ai = k >> 2, m = k & 3; const float rs = rsv[k] * sc;
                    const f32x4 x00 = acc[ai][0][m][0] * rs, x01 = acc[ai][0][m][1] * rs, x10 = acc[ai][1][m][0] * rs, x11 = acc[ai][1][m][1] * rs;
                    const f32x4 o00 = x00 * tc0[mm] - x10 * ts0[mm], o01 = x01 * tc1[mm] - x11 * ts1[mm], o10 = x10 * tc0[mm] + x00 * ts0[mm], o11 = x11 * tc1[mm] + x01 * ts1[mm];
                    const int row = row0 + ai * HALF + m * 16;
                    bf16_t* rp = dst + kv_off(row >> 11, head, row & (SEQ - 1)) + 8 * fq;
                    store_bf16x8(rp, o00, o01); store_bf16x8(rp + 32, o10, o11); }
            }
        }
    }
};
struct EpiOut {
    const bf16_t* x; bf16_t* HB; unsigned char* H8;
    __device__ __forceinline__ void operator()(const f32x4 (&acc)[2][2][4][2], const Unit& u, int wr, int wc, int fr, int fq, const LAS unsigned char* meta) const {
        const int row0 = u.pm * BM + wr * 64 + fr, col0 = u.pn * BM + wc * 32 + 8 * fq;
        u32x4 xw[2][4][2];
#pragma unroll
        for (int ai = 0; ai < 2; ++ai)
#pragma unroll
            for (int m = 0; m < 4; ++m)
#pragma unroll
                for (int bj = 0; bj < 2; ++bj) xw[ai][m][bj] = *(const u32x4*)(x + (size_t)(row0 + ai * HALF + m * 16) * DM + col0 + bj * HALF);
#pragma unroll
        for (int ai = 0; ai < 2; ++ai)
#pragma unroll
            for (int m = 0; m < 4; ++m) {
                const size_t off = (size_t)(row0 + ai * HALF + m * 16) * DM + col0;
#pragma unroll
                for (int bj = 0; bj < 2; ++bj) {
                    const u32x4 q = xw[ai][m][bj];
                    const f32x4 h0 = (f32x4){bf_lo(q.x), bf_hi(q.x), bf_lo(q.y), bf_hi(q.y)} + acc[ai][bj][m][0], h1 = (f32x4){bf_lo(q.z), bf_hi(q.z), bf_lo(q.w), bf_hi(q.w)} + acc[ai][bj][m][1];
                    store_bf16x8(HB + off + bj * HALF, h0, h1);
                    u32x2 w8; w8.x = pk4_fp8(h0[0], h0[1], h0[2], h0[3]); w8.y = pk4_fp8(h1[0], h1[1], h1[2], h1[3]);
                    *(u32x2*)(H8 + off + bj * HALF) = w8;
                }
            }
    }
};
struct EpiGateUp {
    unsigned char* ACT; const float* bgu;
    __device__ __forceinline__ void operator()(const f32x4 (&acc)[2][2][4][2], const Unit& u, int wr, int wc, int fr, int fq, const LAS unsigned char* meta) const {
        const int f0 = u.pn * HALF + wc * 32 + 8 * fq;
        const float* bp = bgu + (size_t)u.e * (2 * DFF) + f0;
        const f32x4 bg0 = *(const f32x4*)(bp), bg1 = *(const f32x4*)(bp + 4), bu0 = *(const f32x4*)(bp + DFF), bu1 = *(const f32x4*)(bp + DFF + 4);
#pragma unroll
        for (int ai = 0; ai < 2; ++ai)
#pragma unroll
            for (int m = 0; m < 4; ++m) {
                const int lr = ai * HALF + wr * 64 + m * 16 + fr;
                const float rs = __uint_as_float(*(const LAS unsigned*)(meta + lr * 8 + 4)) * 0.015625f;
                const f32x4 g0 = acc[ai][0][m][0] * rs + bg0, g1 = acc[ai][0][m][1] * rs + bg1, p0 = acc[ai][1][m][0] * rs + bu0, p1 = acc[ai][1][m][1] * rs + bu1;
                f32x2 a[4];
#pragma unroll
                for (int h2 = 0; h2 < 4; ++h2) {
                    const f32x4 gs = h2 < 2 ? g0 : g1, us = h2 < 2 ? p0 : p1;
                    f32x2 g, u2; g.x = fminf(gs[2 * (h2 & 1)], 7.0f); g.y = fminf(gs[2 * (h2 & 1) + 1], 7.0f);
                    u2.x = __builtin_amdgcn_fmed3f(us[2 * (h2 & 1)], -7.0f, 7.0f); u2.y = __builtin_amdgcn_fmed3f(us[2 * (h2 & 1) + 1], -7.0f, 7.0f);
                    const f32x2 t = g * (-2.4554669595f);
                    f32x2 e; e.x = __builtin_amdgcn_exp2f(t.x); e.y = __builtin_amdgcn_exp2f(t.y);
                    const f32x2 d = e + 1.0f;
                    f32x2 r; r.x = __builtin_amdgcn_rcpf(d.x); r.y = __builtin_amdgcn_rcpf(d.y);
                    a[h2] = ((u2 * 4.0f + 4.0f) * g) * r;
                }
                u32x2 w8; w8.x = pk4_fp8(a[0].x, a[0].y, a[1].x, a[1].y); w8.y = pk4_fp8(a[2].x, a[2].y, a[3].x, a[3].y);
                *(u32x2*)(ACT + (size_t)(u.pm * 8 + u.pn) * 32768 + lr * 128 + wc * 32 + 8 * fq) = w8;
            }
    }
};
struct EpiDown {
    unsigned char* CONTRIB; const float* bd;
    __device__ __forceinline__ void operator()(const f32x4 (&acc)[2][2][4][2], const Unit& u, int wr, int wc, int fr, int fq, const LAS unsigned char* meta) const {
        const int col0 = u.pn * BM + wc * 64 + 16 * fq;
        const float* bp = bd + (size_t)u.e * DM + col0;
        f32x4 b00 = *(const f32x4*)(bp), b01 = *(const f32x4*)(bp + 4), b10 = *(const f32x4*)(bp + 8), b11 = *(const f32x4*)(bp + 12);
        asm volatile("" : "+v"(b00), "+v"(b01), "+v"(b10), "+v"(b11));
#pragma unroll
        for (int ai = 0; ai < 2; ++ai)
#pragma unroll
            for (int m = 0; m < 4; ++m) {
                const int lr = ai * HALF + wr * 64 + m * 16 + fr;
                const u32x2 rec = *(const LAS u32x2*)(meta + lr * 8);
                const bool valid = lr < u.nvalid;
                const float gt = valid ? __uint_as_float(rec.y) * 16.0f : 0.f;
                const f32x4 y00 = (acc[ai][0][m][0] * 0.00390625f + b00) * gt, y01 = (acc[ai][0][m][1] * 0.00390625f + b01) * gt, y10 = (acc[ai][1][m][0] * 0.00390625f + b10) * gt, y11 = (acc[ai][1][m][1] * 0.00390625f + b11) * gt;
                if (valid) {
                    u32x4 w; w.x = pk4_fp8(y00[0], y00[1], y00[2], y00[3]); w.y = pk4_fp8(y01[0], y01[1], y01[2], y01[3]); w.z = pk4_fp8(y10[0], y10[1], y10[2], y10[3]); w.w = pk4_fp8(y11[0], y11[1], y11[2], y11[3]);
                    *(u32x4*)(CONTRIB + (size_t)rec.x * DM + col0) = w;
                }
            }
    }
};
}

#ifndef PROBE_DUP
#define PROBE_DUP -1
#endif
#define REPS(k) ((PROBE_DUP == (k)) ? 2 : 1)
struct Frame {
    LAS unsigned char* lds; int tid, lane, wave, vcu, G, gw, NGW;
};

template <bool GAIN>
__device__ __forceinline__ void tr_item(const float* W, int N, int k0, int n0, const float* gain, bf16_t* wt_row0, LAS float* scr, int lane) {
    const int kr = lane >> 3, nq = lane & 7;
    f32x4 v[8]; float gk[8];
#pragma unroll
    for (int it = 0; it < 8; ++it) { const int k = k0 + 8 * it + kr; v[it] = *(const f32x4*)(W + (size_t)k * N + n0 + 4 * nq); gk[it] = GAIN ? gain[k] : 1.0f; }
    if (GAIN) {
#pragma unroll
        for (int it = 0; it < 8; ++it) v[it] = v[it] * gk[it];
    }
#pragma unroll
    for (int it = 0; it < 8; ++it) *(LAS f32x4*)(scr + (8 * it + kr) * 32 + ((nq ^ it) << 2)) = v[it];
    LDS_WAIT();
    const int nl = lane >> 3, c = lane & 7;
#pragma unroll
    for (int iter = 0; iter < 4; ++iter) {
        const int n = nl + 8 * iter; const LAS float* s = scr + (8 * c) * 32 + (((n >> 2) ^ c) << 2) + (n & 3);
        u32x4 o; o.x = cvt_pk_bf16(s[0], s[32]); o.y = cvt_pk_bf16(s[64], s[96]); o.z = cvt_pk_bf16(s[128], s[160]); o.w = cvt_pk_bf16(s[192], s[224]);
        *(u32x4*)(wt_row0 + (size_t)n * 1024 + k0 + 8 * c) = o;
    }
    LDS_WAIT();
}

template <bool GAIN>
__device__ __forceinline__ void tr_item_f8(const float* W, int N, int k0, int n0, const float* gain, float scale, unsigned char* wt_row0, LAS float* scr, int lane) {
    const int kr = lane >> 3, nq = lane & 7;
    f32x4 v[8]; float gk[8];
#pragma unroll
    for (int it = 0; it < 8; ++it) { const int k = k0 + 8 * it + kr; v[it] = *(const f32x4*)(W + (size_t)k * N + n0 + 4 * nq); gk[it] = GAIN ? gain[k] * scale : scale; }
#pragma unroll
    for (int it = 0; it < 8; ++it) v[it] = v[it] * gk[it];
#pragma unroll
    for (int it = 0; it < 8; ++it) *(LAS f32x4*)(scr + (8 * it + kr) * 32 + ((nq ^ it) << 2)) = v[it];
    LDS_WAIT();
    const int nl = lane >> 2, c = lane & 3;
#pragma unroll
    for (int iter = 0; iter < 2; ++iter) {
        const int n = nl + 16 * iter; float f[16];
#pragma unroll
        for (int j = 0; j < 16; ++j) { const int k = 16 * c + j; f[j] = scr[k * 32 + (((n >> 2) ^ ((k >> 3) & 7)) << 2) + (n & 3)]; }
        u32x4 o; o.x = pk4_fp8(f[0], f[1], f[2], f[3]); o.y = pk4_fp8(f[4], f[5], f[6], f[7]); o.z = pk4_fp8(f[8], f[9], f[10], f[11]); o.w = pk4_fp8(f[12], f[13], f[14], f[15]);
        *(u32x4*)(wt_row0 + (size_t)n * 1024 + k0 + 16 * c) = o;
    }
    LDS_WAIT();
}

template <bool GAIN>
__device__ __forceinline__ void tr_item_f8w(const float* W, int N, int k0, int n0, const float* gain, float scale, unsigned char* wt_row0, LAS float* scr, int lane) {
    const int kr = lane >> 3, nq = lane & 7;
    f32x4 v[16]; float gk[16];
#pragma unroll
    for (int it = 0; it < 16; ++it) { const int k = k0 + 8 * it + kr; v[it] = *(const f32x4*)(W + (size_t)k * N + n0 + 4 * nq); gk[it] = GAIN ? gain[k] * scale : scale; }
#pragma unroll
    for (int it = 0; it < 16; ++it) *(LAS f32x4*)(scr + (8 * it + kr) * 32 + ((nq ^ (it & 7)) << 2)) = v[it] * gk[it];
    LDS_WAIT();
    const int nl = lane >> 3, c = lane & 7;
#pragma unroll
    for (int iter = 0; iter < 4; ++iter) {
        const int n = nl + 8 * iter; float f[16];
#pragma unroll
        for (int j = 0; j < 16; ++j) { const int k = 16 * c + j; f[j] = scr[k * 32 + (((n >> 2) ^ ((k >> 3) & 7)) << 2) + (n & 3)]; }
        u32x4 o; o.x = pk4_fp8(f[0], f[1], f[2], f[3]); o.y = pk4_fp8(f[4], f[5], f[6], f[7]); o.z = pk4_fp8(f[8], f[9], f[10], f[11]); o.w = pk4_fp8(f[12], f[13], f[14], f[15]);
        *(u32x4*)(wt_row0 + (size_t)n * 1024 + k0 + 16 * c) = o;
    }
    LDS_WAIT();
}

__device__ __forceinline__ s16x4 tr_read_asm(const LAS unsigned char* p) { s16x4 r; asm volatile("ds_read_b64_tr_b16 %0, %1" : "=v"(r) : "v"((unsigned)(uintptr_t)p) : "memory"); return r; }
struct AttCtx { const bf16_t* Q; const bf16_t* KB; const bf16_t* VB; bf16_t* BPART; float* LSE; };
__device__ __forceinline__ void att_decode(int idx, int& n, int& b, int& head, int& dil, int& r, int& q0, int& qb) {
    n = idx >> 11; const int rem = idx & 2047; b = rem >> 7; head = (rem >> 4) & 7; const int j = (rem + (idx >> 8)) & 15, sh = 2 * n;
    dil = 1 << sh; r = j & (dil - 1); qb = j >> sh; q0 = qb * 128;
}
template <int BUFI>
__device__ __forceinline__ void att_issue(LAS unsigned char* lds, const AttCtx& C, int idx, int wave, int lane) {
    int n, b, head, dil, r, q0, qb; att_decode(idx, n, b, head, dil, r, q0, qb);
#pragma unroll
    for (int t = 0; t < 4; ++t) { const int row = 32 * wave + 8 * t + (lane >> 3); int l = q0 - 128 + row; l = l < 0 ? 0 : l;
        const size_t off = kv_off(b, head, l * dil + r) + (((lane & 7) ^ (row & 7)) << 3);
        __builtin_amdgcn_global_load_lds((const unsigned*)(C.KB + off), (LAS unsigned*)(lds + BUFI * 65536 + (32 * wave + 8 * t) * 128), 16, 0, 0);
        __builtin_amdgcn_global_load_lds((const unsigned*)(C.VB + off), (LAS unsigned*)(lds + BUFI * 65536 + 32768 + (32 * wave + 8 * t) * 128), 16, 0, 0); }
}
struct AttNext { unsigned off[4]; int on; };
__device__ __forceinline__ AttNext att_prep(int idx, bool on, int wave, int lane) {
    AttNext x; x.on = on ? 1 : 0;
    int n, b, head, dil, r, q0, qb; att_decode(on ? idx : 0, n, b, head, dil, r, q0, qb);
#pragma unroll
    for (int t = 0; t < 4; ++t) { const int row = 32 * wave + 8 * t + (lane >> 3); int l = q0 - 128 + row; l = l < 0 ? 0 : l;
        x.off[t] = (unsigned)(kv_off(b, head, l * dil + r) + (((lane & 7) ^ (row & 7)) << 3)); }
    return x;
}
template <int BUFI>
__device__ __forceinline__ void att_dma(LAS unsigned char* lds, const AttCtx& C, const AttNext& x, int t, int wave) {
    if (x.on) {
        __builtin_amdgcn_global_load_lds((const unsigned*)(C.KB + x.off[t]), (LAS unsigned*)(lds + BUFI * 65536 + (32 * wave + 8 * t) * 128), 16, 0, 0);
        __builtin_amdgcn_global_load_lds((const unsigned*)(C.VB + x.off[t]), (LAS unsigned*)(lds + BUFI * 65536 + 32768 + (32 * wave + 8 * t) * 128), 16, 0, 0);
    }
}
__device__ __forceinline__ void att_load_q(const AttCtx& C, int unit, int wave, int lane, bf16x8 (&qf)[2]) {
    int n, b, head, dil, r, q0, qb; att_decode(unit, n, b, head, dil, r, q0, qb);
    const int tq = (q0 + 16 * wave + (lane & 15)) * dil + r;
#pragma unroll
    for (int s2 = 0; s2 < 2; ++s2) qf[s2] = *(const bf16x8*)(C.Q + kv_off(b, head, tq) + 32 * s2 + 8 * (lane >> 4));
}
__device__ __forceinline__ float xrow_max(float x) {
    const auto r16 = __builtin_amdgcn_permlane16_swap(__float_as_uint(x), __float_as_uint(x), false, false); x = fmaxf(__uint_as_float(r16[0]), __uint_as_float(r16[1]));
    const auto r32 = __builtin_amdgcn_permlane32_swap(__float_as_uint(x), __float_as_uint(x), false, false); return fmaxf(__uint_as_float(r32[0]), __uint_as_float(r32[1]));
}
__device__ __forceinline__ float xrow_sum(float x) {
    const auto r16 = __builtin_amdgcn_permlane16_swap(__float_as_uint(x), __float_as_uint(x), false, false); x = __uint_as_float(r16[0]) + __uint_as_float(r16[1]);
    const auto r32 = __builtin_amdgcn_permlane32_swap(__float_as_uint(x), __float_as_uint(x), false, false); return __uint_as_float(r32[0]) + __uint_as_float(r32[1]);
}
template <int OFF>
__device__ __forceinline__ s16x4 tr_read_off(unsigned addr) { s16x4 r; asm volatile("ds_read_b64_tr_b16 %0, %1 offset:%2" : "=v"(r) : "v"(addr), "n"(OFF) : "memory"); return r; }
template <int BUFI>
__device__ __forceinline__ float att_unit(LAS unsigned char* lds, const AttCtx& C, int unit, int wave, int lane, const bf16x8 (&qf)[2], const AttNext& nx) {
    const int qi = lane & 15, g = lane >> 4, li = lane & 15;
    int n, b, head, dil, r, q0, qb; att_decode(unit, n, b, head, dil, r, q0, qb);
    const LAS unsigned char* kl = lds + BUFI * 65536; const LAS unsigned char* vl = kl + 32768;
    const int kt0 = (qb == 0) ? (8 - wave) : 0;
    att_dma<BUFI ^ 1>(lds, C, nx, 0, wave);
    f32x4 S[9];
    const LAS unsigned char* kbase = kl + (16 * wave + qi) * 128;
#pragma unroll
    for (int kt = 0; kt < 9; ++kt) {
        f32x4 a = {0.f, 0.f, 0.f, 0.f};
#pragma unroll
        for (int s2 = 0; s2 < 2; ++s2) {
            const bf16x8 kf = *(const LAS bf16x8*)(kbase + kt * 2048 + (((4 * s2 + g) ^ (qi & 7)) << 4));
            a = __builtin_amdgcn_mfma_f32_16x16x32_bf16(kf, qf[s2], a, 0, 0, 0);
        }
#pragma unroll
        for (int v = 0; v < 4; ++v) { const int c = 4 * g + v; bool ok = true; if (kt == 0) ok = c >= qi; if (kt == 8) ok = c <= qi; S[kt][v] = ok ? a[v] : -1e30f; }
    }
    att_dma<BUFI ^ 1>(lds, C, nx, 1, wave);
    float mx = -1e30f;
#pragma unroll
    for (int kt = 0; kt < 9; ++kt) { const float tm = fmaxf(fmaxf(S[kt][0], S[kt][1]), fmaxf(S[kt][2], S[kt][3])); mx = fmaxf(mx, kt >= kt0 ? tm : -1e30f); }
    mx = xrow_max(mx);
    float lsum = 0.f;
#pragma unroll
    for (int kt = 0; kt < 9; ++kt) { const float mk = kt >= kt0 ? mx : 3.0e38f;
#pragma unroll
        for (int v = 0; v < 4; ++v) { const float pv = __builtin_amdgcn_exp2f(S[kt][v] - mk); S[kt][v] = pv; lsum += pv; } }
    lsum = xrow_sum(lsum);
    att_dma<BUFI ^ 1>(lds, C, nx, 2, wave);
    f32x4 o[4];
#pragma unroll
    for (int dt = 0; dt < 4; ++dt) o[dt] = (f32x4){0.f, 0.f, 0.f, 0.f};
    unsigned vb[4];
    { const int row0 = 16 * wave + 4 * g + (li >> 2), pp = li & 3;
#pragma unroll
      for (int dt = 0; dt < 4; ++dt) vb[dt] = (unsigned)(uintptr_t)(vl + row0 * 128 + (((2 * dt + (pp >> 1)) ^ (row0 & 7)) << 4) + 8 * (pp & 1)); }
    s16x4 lo[2][4], hi[2][4];
#define ATT_TR(set, KA, KB) do { _Pragma("unroll") for (int dt = 0; dt < 4; ++dt) { lo[set][dt] = tr_read_off<(KA) * 2048>(vb[dt]); hi[set][dt] = tr_read_off<(KB) * 2048>(vb[dt]); } } while (0)
#define ATT_PV(set, KA, KB, PAIRED, WAITN) do { \
        u32x4 pw; pw.x = cvt_pk_bf16(S[KA][0], S[KA][1]); pw.y = cvt_pk_bf16(S[KA][2], S[KA][3]); \
        if (PAIRED) { pw.z = cvt_pk_bf16(S[KB][0], S[KB][1]); pw.w = cvt_pk_bf16(S[KB][2], S[KB][3]); } else { pw.z = 0u; pw.w = 0u; } \
        const bf16x8 pb = __builtin_bit_cast(bf16x8, pw); \
        asm volatile("s_waitcnt lgkmcnt(" #WAITN ")" : "+v"(lo[set][0]), "+v"(lo[set][1]), "+v"(lo[set][2]), "+v"(lo[set][3]), "+v"(hi[set][0]), "+v"(hi[set][1]), "+v"(hi[set][2]), "+v"(hi[set][3]) :: "memory"); __builtin_amdgcn_sched_barrier(0); \
        _Pragma("unroll") for (int dt = 0; dt < 4; ++dt) { \
            const bf16x8 va = (bf16x8){lo[set][dt][0], lo[set][dt][1], lo[set][dt][2], lo[set][dt][3], hi[set][dt][0], hi[set][dt][1], hi[set][dt][2], hi[set][dt][3]}; \
            o[dt] = __builtin_amdgcn_mfma_f32_16x16x32_bf16(va, pb, o[dt], 0, 0, 0); } } while (0)
    ATT_TR(0, 0, 1);
    ATT_TR(1, 2, 3); ATT_PV(0, 0, 1, true, 8);
    ATT_TR(0, 4, 5); ATT_PV(1, 2, 3, true, 8);
    att_dma<BUFI ^ 1>(lds, C, nx, 3, wave);
    ATT_TR(1, 6, 7); ATT_PV(0, 4, 5, true, 8);
    ATT_TR(0, 8, 8); ATT_PV(1, 6, 7, true, 8);
    ATT_PV(0, 8, 8, false, 0);
#undef ATT_TR
#undef ATT_PV
    const float inv = 1.0f / lsum;
    LAS unsigned char* ost = lds + (OST_OFF - RING_OFF) + wave * 2048;
#pragma unroll
    for (int dt = 0; dt < 4; ++dt) { u32x2 w; w.x = cvt_pk_bf16(o[dt][0] * inv, o[dt][1] * inv); w.y = cvt_pk_bf16(o[dt][2] * inv, o[dt][3] * inv); *(LAS u32x2*)(ost + qi * 128 + 32 * dt + 8 * g) = w; }
    return mx + __builtin_amdgcn_logf(lsum);
}
__device__ __forceinline__ void att_store(LAS unsigned char* lds, const AttCtx& C, int unit, int wave, int lane, float lse) {
    int n, b, head, dil, r, q0, qb; att_decode(unit, n, b, head, dil, r, q0, qb);
    const LAS unsigned char* ost = lds + (OST_OFF - RING_OFF) + wave * 2048;
    LDS_WAIT();
#pragma unroll
    for (int jr = 0; jr < 2; ++jr) {
        const int row = 8 * jr + (lane >> 3), tr = (q0 + 16 * wave + row) * dil + r;
        const u32x4 ov = *(const LAS u32x4*)(ost + row * 128 + (lane & 7) * 16);
        *(u32x4*)(C.BPART + (size_t)n * T * AW + kv_off(b, head, tr) + (lane & 7) * 8) = ov;
    }
    const int tq = (q0 + 16 * wave + (lane & 15)) * dil + r;
    if ((lane >> 4) == 0) C.LSE[(size_t)n * T * NH + kv_off(b, head, tq) / HD] = lse;
    LDS_WAIT();
}

struct Args { const float* in[18]; float* out; unsigned char* ws; };
typedef const __attribute__((address_space(4))) Args* KArgs;
__device__ __forceinline__ KArgs kargs() { KArgs p = (KArgs)__builtin_amdgcn_kernarg_segment_ptr(); asm volatile("" : "+s"(p)); return p; }
#define KIN(k) (ka->in[k])
#define KWS(Tp, off) ((Tp*)(ka->ws + (off)))
constexpr int CV_I_IN = 16 * (INW / 32), CV_I_OUT = 16 * (DM / 32), CV_I_GU = NE * 8 * (2 * DFF / 32), CV_I_D = NE * 8 * (DM / 32), CV_NITEMS = CV_I_IN + CV_I_OUT + CV_I_GU + CV_I_D;
__device__ __forceinline__ void convert_items(LAS float* scr, int lane, int gw, int NGW, int it_begin, int it_end) {
    const KArgs ka = kargs();
    const float* const norm1_g = KIN(1); const float* const w_in = KIN(2); const float* const a_out_g = KIN(7); const float* const b_out_g = KIN(8); const float* const w_out = KIN(9); const float* const norm2_g = KIN(10);
    const float* const w_gate_up = KIN(13); const float* const w_down = KIN(15);
    bf16_t* const WIN = KWS(bf16_t, WS_WIN); bf16_t* const WOUT = KWS(bf16_t, WS_WOUT); unsigned char* const WGU = KWS(unsigned char, WS_WGU); unsigned char* const WD = KWS(unsigned char, WS_WD);
    constexpr int I_IN = CV_I_IN, I_OUT = CV_I_OUT, I_GU = CV_I_GU;
        for (int it = it_begin + gw; it < it_end; it += NGW) {
        int r = it;
        if (r < I_IN) { const int nb = r % (INW / 32), kb = r / (INW / 32), n0 = nb * 32, tile = n0 >> 8, within = n0 & 255, wcc = within >> 6, bj = (within >> 5) & 1;
            tr_item<true>(w_in, INW, kb * 64, n0, norm1_g, WIN + (size_t)(tile * 256 + 128 * bj + 32 * wcc) * 1024, scr, lane); continue; }
        r -= I_IN;
        if (r < I_OUT) { const int nb = r % (DM / 32), kb = r / (DM / 32), n0 = nb * 32, k0 = kb * 64;
            tr_item<true>(w_out, DM, k0, n0, k0 < AW ? a_out_g : b_out_g - AW, WOUT + (size_t)n0 * 1024, scr, lane); continue; }
        r -= I_OUT;
        if (r < I_GU) { const int e = r / (8 * 64), rr = r % (8 * 64), nb = rr % 64, kb = rr / 64, n0 = nb * 32, bj = n0 >> 10, f = n0 & 1023, pn = f >> 7, wcc = (f >> 5) & 3;
            tr_item_f8w<true>(w_gate_up + (size_t)e * 1024 * 2048, 2 * DFF, kb * 128, n0, norm2_g, 64.0f, WGU + ((size_t)e * 2048 + pn * 256 + 128 * bj + 32 * wcc) * 1024, scr, lane); continue; }
        r -= I_GU;
        { const int e = r / (8 * 32), rr = r % (8 * 32), nb = rr % 32, kb = rr / 32, n0 = nb * 32;
            tr_item_f8w<false>(w_down + (size_t)e * 1024 * 1024, DM, kb * 128, n0, nullptr, 64.0f, WD + ((size_t)e * 1024 + n0) * 1024, scr, lane); }
    }
}

struct CvX { const float* src; unsigned char* dst; int N, gb, gu; };
constexpr int CVW_GU = NE * 8 * 8, CVW_D = NE * 8 * 4, CVW_N = CVW_GU + CVW_D;
__device__ __forceinline__ CvX cvx_decode(int r, int wave, const float* w_gate_up, const float* w_down, unsigned char* WGU, unsigned char* WD) {
    CvX d;
    if (r < CVW_GU) { const int e = r >> 6, kb = (r >> 3) & 7, nb = r & 7, k0 = kb * 128 + 16 * wave;
        d.src = w_gate_up + (size_t)e * 1024 * 2048 + (size_t)k0 * 2048 + nb * 256; d.N = 2 * DFF; d.gb = k0; d.gu = 1;
        const int bj = nb >> 2, pn0 = (nb & 3) * 2;
        d.dst = WGU + (size_t)(e * 8 + pn0) * 262144 + kb * 32768 + (128 * bj) * 128; }
    else { const int q = r - CVW_GU, e = q >> 5, kb = (q >> 2) & 7, nb = q & 3, k0 = kb * 128 + 16 * wave;
        d.src = w_down + (size_t)e * 1024 * 1024 + (size_t)k0 * 1024 + nb * 256; d.N = DM; d.gb = 1024; d.gu = 0;
        d.dst = WD + (size_t)(e * 4 + nb) * 262144 + kb * 32768; }
    return d;
}
__device__ __forceinline__ void cvx_load(const CvX& d, int lane, f32x4 (&v)[16]) {
#pragma unroll
    for (int kk = 0; kk < 16; ++kk) v[kk] = __builtin_nontemporal_load((const f32x4*)(d.src + (size_t)kk * d.N + 4 * lane));
}
__device__ __forceinline__ void cvx_process(const CvX& d, const f32x4 (&v)[16], const LAS float* gtab, LAS unsigned char* img, int lane, int wave) {
    float g[16];
#pragma unroll
    for (int kk = 0; kk < 16; ++kk) g[kk] = gtab[d.gb + kk];
#pragma unroll
    for (int i = 0; i < 4; ++i) {
        u32x4 o; const int c = 4 * lane + i;
        o.x = pk4_fp8(v[0][i] * g[0], v[1][i] * g[1], v[2][i] * g[2], v[3][i] * g[3]); o.y = pk4_fp8(v[4][i] * g[4], v[5][i] * g[5], v[6][i] * g[6], v[7][i] * g[7]);
        o.z = pk4_fp8(v[8][i] * g[8], v[9][i] * g[9], v[10][i] * g[10], v[11][i] * g[11]); o.w = pk4_fp8(v[12][i] * g[12], v[13][i] * g[13], v[14][i] * g[14], v[15][i] * g[15]);
        *(LAS u32x4*)(img + c * 128 + ((wave ^ (c & 7)) << 4)) = o;
    }
    LDS_WAIT(); __builtin_amdgcn_s_barrier(); asm volatile("" ::: "memory");
#pragma unroll
    for (int t = 0; t < 4; ++t) {
        const int c = 32 * wave + 8 * t + (lane >> 3), j = lane & 7, rowb = d.gu ? ((c >> 7) * 262144 + (c & 127) * 128) : c * 128;
        const u32x4 o = *(const LAS u32x4*)(img + c * 128 + ((j ^ (c & 7)) << 4));
        *(u32x4*)(d.dst + rowb + 16 * j) = o;
    }
}
__device__ __forceinline__ void convert_experts(const LAS float* gtab, LAS unsigned char* img, int lane, int wave, int vcu, int G) {
    const KArgs ka = kargs();
    const float* const w_gate_up = KIN(13); const float* const w_down = KIN(15); unsigned char* const WGU = KWS(unsigned char, WS_WGU); unsigned char* const WD = KWS(unsigned char, WS_WD);
    constexpr int NI = CVW_N;
    f32x4 va[16], vb[16];
    int it = vcu; if (it >= NI) return;
    CvX da = cvx_decode(it, wave, w_gate_up, w_down, WGU, WD), db; cvx_load(da, lane, va);
    for (;;) {
        int nx = it + G;
        db = cvx_decode(nx < NI ? nx : it, wave, w_gate_up, w_down, WGU, WD); cvx_load(db, lane, vb);
        cvx_process(da, va, gtab, img, lane, wave);
        if (nx >= NI) break;
        it = nx; nx = it + G;
        da = cvx_decode(nx < NI ? nx : it, wave, w_gate_up, w_down, WGU, WD); cvx_load(da, lane, va);
        cvx_process(db, vb, gtab, img + 32768, lane, wave);
        if (nx >= NI) break;
        it = nx;
    }
}

__global__ void __launch_bounds__(512, 2) fwd_kernel(Args args) {
    extern __shared__ __attribute__((aligned(16))) unsigned char lds_raw[];
    Frame F;
    F.lds = (LAS unsigned char*)lds_raw;
    F.tid = 0; F.lane = 0; F.wave = __builtin_amdgcn_readfirstlane((int)threadIdx.x >> 6);
    F.G = gridDim.x; { const int bx = blockIdx.x; F.vcu = (F.G % 8 == 0) ? (bx % 8) * (F.G / 8) + bx / 8 : bx; }
    F.gw = F.vcu * 8 + F.wave; F.NGW = F.G * 8;
    const int wave = F.wave;
    gu32* const ctl = (gu32*)(kargs()->ws + WS_CTL);

    for (int u = threadIdx.x; u < (LDS_BYTES - LDSCTL_OFF) / 4; u += 512) ((LAS unsigned*)(F.lds + LDSCTL_OFF))[u] = 0u;
    __syncthreads();
    XcdBarrier bar = xcd_barrier_post((unsigned*)(ctl + CW_BAR), (volatile LAS unsigned*)(F.lds + MISC_OFF) + 8);

    for (int rep = 0; rep < REPS(0); ++rep) {
        const int tid = fresh_tid(), lane = tid & 63;
        const KArgs ka = kargs();
        const float* const x = KIN(0); const float* const norm1_g = KIN(1); const float* const w_in = KIN(2); const float* const a_w_s = KIN(5);
        const float* const a_out_g = KIN(7); const float* const b_out_g = KIN(8); const float* const w_out = KIN(9); const float* const norm2_g = KIN(10); const float* const w_router = KIN(11);
        const float* const w_gate_up = KIN(13); const float* const w_down = KIN(15);
        bf16_t* const WRH = KWS(bf16_t, WS_WRT); bf16_t* const WRL = KWS(bf16_t, WS_WRT + 64 * KiB); bf16_t* const WSB = KWS(bf16_t, WS_WSB); float* const COS = KWS(float, WS_COS); float* const SIN = KWS(float, WS_SIN); float* const R1 = KWS(float, WS_R1);
        bf16_t* const WIN = KWS(bf16_t, WS_WIN); bf16_t* const WOUT = KWS(bf16_t, WS_WOUT); unsigned char* const WGU = KWS(unsigned char, WS_WGU); unsigned char* const WD = KWS(unsigned char, WS_WD); bf16_t* const XB = KWS(bf16_t, WS_XB);
        LAS float* scr = (LAS float*)(F.lds + RING_OFF + wave * 16384);
        convert_items(scr, lane, F.gw, F.NGW, 0, CV_I_IN + CV_I_OUT);
        for (int m0 = F.gw; m0 < T; m0 += 4 * F.NGW) {
            f32x4 v[4][4];
#pragma unroll
            for (int q = 0; q < 4; ++q) { const f32x4* xr = (const f32x4*)(x + (size_t)(m0 + q * F.NGW) * DM) + lane;
#pragma unroll
                for (int j = 0; j < 4; ++j) v[q][j] = __builtin_nontemporal_load(xr + 64 * j); }
#pragma unroll
            for (int q = 0; q < 4; ++q) {
                const int m = m0 + q * F.NGW; float sq = 0.f;
#pragma unroll
                for (int j = 0; j < 4; ++j) sq += (v[q][j].x * v[q][j].x + v[q][j].y * v[q][j].y) + (v[q][j].z * v[q][j].z + v[q][j].w * v[q][j].w);
                sq = wave_sum(sq);
                u32x2* o8 = (u32x2*)(XB + (size_t)m * DM) + lane;
#pragma unroll
                for (int j = 0; j < 4; ++j) { u32x2 w; w.x = cvt_pk_bf16(v[q][j].x, v[q][j].y); w.y = cvt_pk_bf16(v[q][j].z, v[q][j].w); o8[64 * j] = w; }
                if (lane == 0) R1[m] = 1.0f / sqrtf(sq * (1.0f / DM) + NORM_EPS);
            }
        }
        const int gt = F.vcu * 512 + tid, NGT = F.G * 512;
        for (int i = gt; i < SEQ * 32; i += NGT) {
            const int pos = i >> 5, d = i & 31;
            const float inv = (float)exp2(-(double)(2 * d) * (13.287712379549449 / 64.0));
            const float ang = (float)pos * inv;
            const double a = (double)ang; const double kq = rint(a * 0.15915494309189535); const float rr = (float)(a - kq * 6.283185307179586);
            COS[i] = cosf(rr); SIN[i] = sinf(rr);
        }
        for (int i = gt; i < NH * CHUNK * CHUNK; i += NGT) { const int s = i & 127, t = (i >> 7) & 127; const float w = (s <= t) ? a_w_s[i] : 0.f; WSB[i] = (bf16_t)(cvt_pk_bf16(w, 0.f) & 0xffffu); }
        for (int i = gt; i < NE * DM; i += NGT) {
            const int e = i >> 10, k = i & 1023; const float w = w_router[k * NE + e] * norm2_g[k];
            const unsigned hi = cvt_pk_bf16(w, 0.f) & 0xffffu; const float lo = w - __uint_as_float(hi << 16);
            WRH[i] = (bf16_t)hi; WRL[i] = (bf16_t)(cvt_pk_bf16(lo, 0.f) & 0xffffu); }
    }
    xcd_barrier(bar);

    for (int rep = 0; rep < REPS(1); ++rep) {
        const KArgs ka = kargs();
        pg8::DenseSched S{KWS(const char, WS_XB), KWS(const char, WS_WIN), T / 256, INW / 256, F.G, (int)blockIdx.x};
        pg8::EpiProj E{KWS(bf16_t, WS_U), KWS(bf16_t, WS_VN), KWS(bf16_t, WS_Q), KWS(bf16_t, WS_K), KWS(bf16_t, WS_V), KWS(float, WS_R1), KWS(float, WS_COS), KWS(float, WS_SIN), KIN(3), KIN(4)};
        pg8::gemm_phase<pg8::EpiProj, pg8::DenseSched>(F.lds + RING_OFF, S, E);
    }
    xcd_barrier(bar);

    for (int rep = 0; rep < REPS(2); ++rep)
    for (int unit = F.vcu; unit < BATCH * (SEQ / CHUNK); unit += F.G) {
        const int tid = fresh_tid(), lane = tid & 63; (void)tid;
        const KArgs ka = kargs();
        const float* const a_b_s = KIN(6); const bf16_t* const VN = KWS(bf16_t, WS_VN); const bf16_t* const U = KWS(bf16_t, WS_U); const bf16_t* const WSB = KWS(bf16_t, WS_WSB); bf16_t* const MIXED = KWS(bf16_t, WS_MIXED);
        const int tok0 = unit * CHUNK, h = wave, hh = lane >> 5, g16 = lane >> 4, li = lane & 15;
        LAS unsigned char* vl = F.lds + RING_OFF + wave * 16384;
        {
            const int cc = lane & 7, rb = lane >> 3;
            u32x4 tmp[16];
#pragma unroll
            for (int it = 0; it < 16; ++it) { const int row = rb + 8 * it; tmp[it] = *(const u32x4*)(VN + (size_t)(tok0 + row) * AW + h * HD + cc * 8); }
#pragma unroll
            for (int it = 0; it < 16; ++it) { const int row = rb + 8 * it; *(LAS u32x4*)(vl + row * 128 + ((cc ^ (row & 7)) << 4)) = tmp[it]; }
            LDS_WAIT();
        }
        bf16x8 wsf[10][2];
#pragma unroll
        for (int tb = 0; tb < 4; ++tb)
#pragma unroll
            for (int st = 0; st <= tb; ++st)
#pragma unroll
                for (int s2 = 0; s2 < 2; ++s2) wsf[tb * (tb + 1) / 2 + st][s2] = *(const bf16x8*)(WSB + ((size_t)h * CHUNK + 32 * tb + (lane & 31)) * CHUNK + 32 * st + 16 * s2 + 8 * hh);
        f32x16 araw[4][2];
#pragma unroll
        for (int tb = 0; tb < 4; ++tb) {
            f32x16 g0, g1;
#pragma unroll
            for (int v = 0; v < 16; ++v) { g0[v] = 0.f; g1[v] = 0.f; }
            const int t = 32 * tb + (lane & 31);
#pragma unroll
            for (int st = 0; st <= tb; ++st)
#pragma unroll
                for (int s2 = 0; s2 < 2; ++s2) {
                    const int s0 = 32 * st + 16 * s2;
                    const bf16x8 wb = wsf[tb * (tb + 1) / 2 + st][s2];
                    const int rowa = s0 + 8 * hh + (li >> 2), rowb = rowa + 4, pp = li & 3;
#pragma unroll
                    for (int dt = 0; dt < 2; ++dt) {
                        const int chunk = 4 * dt + 2 * (g16 & 1) + (pp >> 1);
                        const s16x4 lo = __builtin_bit_cast(s16x4, __builtin_amdgcn_ds_read_tr16_b64_v4i16((LAS s16x4*)(vl + rowa * 128 + ((chunk ^ (rowa & 7)) << 4) + 8 * (pp & 1))));
                        const s16x4 hi = __builtin_bit_cast(s16x4, __builtin_amdgcn_ds_read_tr16_b64_v4i16((LAS s16x4*)(vl + rowb * 128 + ((chunk ^ (rowb & 7)) << 4) + 8 * (pp & 1))));
                        const bf16x8 va = (bf16x8){lo[0], lo[1], lo[2], lo[3], hi[0], hi[1], hi[2], hi[3]};
                        if (dt == 0) g0 = __builtin_amdgcn_mfma_f32_32x32x16_bf16(va, wb, g0, 0, 0, 0); else g1 = __builtin_amdgcn_mfma_f32_32x32x16_bf16(va, wb, g1, 0, 0, 0);
                    }
                }
            araw[tb][0] = g0; araw[tb][1] = g1;
        }
        {
            LDS_WAIT();
            const int cc = lane & 7, rb = lane >> 3;
            u32x4 tmp[16];
#pragma unroll
            for (int it = 0; it < 16; ++it) { const int row = rb + 8 * it; tmp[it] = *(const u32x4*)(U + (size_t)(tok0 + row) * AW + h * HD + cc * 8); }
#pragma unroll
            for (int it = 0; it < 16; ++it) { const int row = rb + 8 * it; *(LAS u32x4*)(vl + row * 128 + ((cc ^ (row & 7)) << 4)) = tmp[it]; }
            LDS_WAIT();
        }
#pragma unroll
        for (int tb = 0; tb < 4; ++tb) {
            const int t = 32 * tb + (lane & 31);
            const float bias = a_b_s[h * CHUNK + t];
            float sq = 0.f;
#pragma unroll
            for (int g = 0; g < 4; ++g) {
                const u32x2 u0 = *(const LAS u32x2*)(vl + t * 128 + ((g ^ (t & 7)) << 4) + 8 * hh), u1 = *(const LAS u32x2*)(vl + t * 128 + (((4 + g) ^ (t & 7)) << 4) + 8 * hh);
                const float a0 = bf_lo(u0.x) * (araw[tb][0][4 * g] + bias), a1 = bf_hi(u0.x) * (araw[tb][0][4 * g + 1] + bias), a2 = bf_lo(u0.y) * (araw[tb][0][4 * g + 2] + bias), a3 = bf_hi(u0.y) * (araw[tb][0][4 * g + 3] + bias);
                const float c0 = bf_lo(u1.x) * (araw[tb][1][4 * g] + bias), c1 = bf_hi(u1.x) * (araw[tb][1][4 * g + 1] + bias), c2 = bf_lo(u1.y) * (araw[tb][1][4 * g + 2] + bias), c3 = bf_hi(u1.y) * (araw[tb][1][4 * g + 3] + bias);
                araw[tb][0][4 * g] = a0; araw[tb][0][4 * g + 1] = a1; araw[tb][0][4 * g + 2] = a2; araw[tb][0][4 * g + 3] = a3;
                araw[tb][1][4 * g] = c0; araw[tb][1][4 * g + 1] = c1; araw[tb][1][4 * g + 2] = c2; araw[tb][1][4 * g + 3] = c3;
                sq += (a0 * a0 + a1 * a1) + (a2 * a2 + a3 * a3) + (c0 * c0 + c1 * c1) + (c2 * c2 + c3 * c3);
            }
            sq += __shfl_xor(sq, 32);
            if (lane < 32) ((LAS float*)(F.lds + EXCH_OFF))[h * CHUNK + t] = sq;
        }
        __syncthreads();
#pragma unroll
        for (int tb = 0; tb < 4; ++tb) {
            const int t = 32 * tb + (lane & 31);
            float tot = 0.f;
#pragma unroll
            for (int k = 0; k < NH; ++k) tot += ((LAS float*)(F.lds + EXCH_OFF))[k * CHUNK + t];
            const float rstd = 1.0f / sqrtf(tot * (1.0f / AW) + NORM_EPS);
#pragma unroll
            for (int g = 0; g < 4; ++g) {
                u32x2 w0, w1;
                w0.x = cvt_pk_bf16(araw[tb][0][4 * g] * rstd, araw[tb][0][4 * g + 1] * rstd); w0.y = cvt_pk_bf16(araw[tb][0][4 * g + 2] * rstd, araw[tb][0][4 * g + 3] * rstd);
                w1.x = cvt_pk_bf16(araw[tb][1][4 * g] * rstd, araw[tb][1][4 * g + 1] * rstd); w1.y = cvt_pk_bf16(araw[tb][1][4 * g + 2] * rstd, araw[tb][1][4 * g + 3] * rstd);
                *(LAS u32x2*)(vl + t * 128 + ((g ^ (t & 7)) << 4) + 8 * hh) = w0; *(LAS u32x2*)(vl + t * 128 + (((4 + g) ^ (t & 7)) << 4) + 8 * hh) = w1;
            }
        }
        {
            LDS_WAIT();
            const int cc = lane & 7, rb = lane >> 3;
#pragma unroll
            for (int it = 0; it < 16; ++it) { const int row = rb + 8 * it; const u32x4 o = *(const LAS u32x4*)(vl + row * 128 + ((cc ^ (row & 7)) << 4)); *(u32x4*)(MIXED + (size_t)(tok0 + row) * DM + h * HD + cc * 8) = o; }
        }
        __syncthreads();
    }

    {
        const int tid = fresh_tid(), lane = tid & 63; (void)tid;
        const KArgs ka = kargs();
        const AttCtx C{KWS(bf16_t, WS_Q), KWS(bf16_t, WS_K), KWS(bf16_t, WS_V), KWS(bf16_t, WS_BPART), KWS(float, WS_LSE)};
        constexpr int NUNIT = 3 * 2048;
        LAS unsigned char* const al = F.lds + RING_OFF;
        bf16x8 qa[2], qb2[2];
        if (F.vcu < NUNIT) { att_issue<0>(al, C, F.vcu, wave, lane); att_load_q(C, F.vcu, wave, lane, qa); }
        __syncthreads();
        float lse = 0.f; int prev = -1;
        for (int unit = F.vcu; unit < NUNIT; unit += 2 * F.G) {
            { const bool on = unit + F.G < NUNIT; const AttNext nx = att_prep(unit + F.G, on, wave, lane);
              if (on) att_load_q(C, unit + F.G, wave, lane, qb2);
              if (prev >= 0) att_store(al, C, prev, wave, lane, lse);
              lse = att_unit<0>(al, C, unit, wave, lane, qa, nx); prev = unit; }
            __syncthreads();
            if (unit + F.G < NUNIT) {
                const bool on = unit + 2 * F.G < NUNIT; const AttNext nx = att_prep(unit + 2 * F.G, on, wave, lane);
                if (on) att_load_q(C, unit + 2 * F.G, wave, lane, qa);
                att_store(al, C, prev, wave, lane, lse);
                lse = att_unit<1>(al, C, unit + F.G, wave, lane, qb2, nx); prev = unit + F.G;
                __syncthreads();
            }
        }
        if (prev >= 0) att_store(al, C, prev, wave, lane, lse);
    }
    xcd_barrier(bar);

    for (int rep = 0; rep < REPS(4); ++rep)
    for (int mo = F.gw; mo < T; mo += F.NGW) {
        const int m = (mo & ~(SEQ - 1)) + ((mo & 127) << 4) + ((mo >> 7) & 15);
        const int lane = fresh_tid() & 63;
        const KArgs ka = kargs();
        const bf16_t* const BPART = KWS(bf16_t, WS_BPART); const float* const LSE = KWS(float, WS_LSE); bf16_t* const MIXED = KWS(bf16_t, WS_MIXED);
        const int head = lane >> 3;
        float L[3]; u32x4 ov[3];
#pragma unroll
        for (int n = 0; n < 3; ++n) { const size_t ro = kv_off(m >> 11, head, m & (SEQ - 1)); L[n] = LSE[(size_t)n * T * NH + ro / HD]; ov[n] = *(const u32x4*)(BPART + (size_t)n * T * AW + ro + (lane & 7) * 8); }
        const float mx = fmaxf(L[0], fmaxf(L[1], L[2]));
        float w[3]; w[0] = __builtin_amdgcn_exp2f(L[0] - mx); w[1] = __builtin_amdgcn_exp2f(L[1] - mx); w[2] = __builtin_amdgcn_exp2f(L[2] - mx);
        const float inv = 1.0f / (w[0] + w[1] + w[2]);
        float o[8];
#pragma unroll
        for (int k = 0; k < 8; ++k) o[k] = 0.f;
#pragma unroll
        for (int n = 0; n < 3; ++n) { const float wn = w[n] * inv;
            o[0] += wn * bf_lo(ov[n].x); o[1] += wn * bf_hi(ov[n].x); o[2] += wn * bf_lo(ov[n].y); o[3] += wn * bf_hi(ov[n].y);
            o[4] += wn * bf_lo(ov[n].z); o[5] += wn * bf_hi(ov[n].z); o[6] += wn * bf_lo(ov[n].w); o[7] += wn * bf_hi(ov[n].w); }
        float s = 0.f;
#pragma unroll
        for (int k = 0; k < 8; ++k) s += o[k] * o[k];
        s = wave_sum(s);
        const float rstd = 1.0f / sqrtf(s * (1.0f / AW) + NORM_EPS);
        u32x4 wv; wv.x = cvt_pk_bf16(o[0] * rstd, o[1] * rstd); wv.y = cvt_pk_bf16(o[2] * rstd, o[3] * rstd); wv.z = cvt_pk_bf16(o[4] * rstd, o[5] * rstd); wv.w = cvt_pk_bf16(o[6] * rstd, o[7] * rstd);
        *(u32x4*)(MIXED + (size_t)m * DM + AW + lane * 8) = wv;
    }
    xcd_barrier(bar);

    for (int rep = 0; rep < REPS(5); ++rep) {
        const KArgs ka = kargs();
        pg8::DenseSched S{KWS(const char, WS_MIXED), KWS(const char, WS_WOUT), T / 256, DM / 256, F.G, (int)blockIdx.x};
        pg8::EpiOut E{KWS(const bf16_t, WS_XB), KWS(bf16_t, WS_HB), KWS(unsigned char, WS_H)};
        pg8::gemm_phase<pg8::EpiOut, pg8::DenseSched>(F.lds + RING_OFF, S, E);
    }
    xcd_barrier(bar);

    { const KArgs ka = kargs(); const float* const norm2_g = KIN(10); LAS float* gt = (LAS float*)(F.lds + GTAB_OFF);
      for (int i = fresh_tid(); i < DM + 128; i += 512) gt[i] = i < DM ? norm2_g[i] * 64.0f : 64.0f;
      __syncthreads(); }
    if (F.vcu & 1) { convert_experts((const LAS float*)(F.lds + GTAB_OFF), F.lds + RING_OFF, fresh_tid() & 63, wave, F.vcu, F.G); __syncthreads(); }
    for (int blk = F.vcu; blk < T / 128; blk += F.G) {
        const int tid = fresh_tid(), lane = tid & 63;
        const KArgs ka = kargs();
        const float* const b_router = KIN(12); const bf16_t* const HB = KWS(bf16_t, WS_HB); const bf16_t* const WRH = KWS(bf16_t, WS_WRT); const bf16_t* const WRL = KWS(bf16_t, WS_WRT + 64 * KiB); float* const R2 = KWS(float, WS_R2);
        u32x2* const LISTR = KWS(u32x2, WS_LISTR); u32x2* const LISTG = KWS(u32x2, WS_LISTG);
        const int t0 = blk * 128 + wave * 16, nn = lane & 15, q4 = lane >> 4, kb = 128 * wave;
        LAS float* part = (LAS float*)(F.lds + RING_OFF) + wave * 4096;
        LAS float* ssqp = (LAS float*)(F.lds + EXCH_OFF) + wave * 128;
        LAS float* lg = (LAS float*)(F.lds + META_OFF + wave * 2816);
        LAS int* selE = (LAS int*)(F.lds + META_OFF + wave * 2816 + 2112);
        LAS float* selG = (LAS float*)(F.lds + META_OFF + wave * 2816 + 2368);
        LAS int* hist = (LAS int*)(F.lds + HIST_OFF); LAS int* basee = hist + 32;
        if (tid < 32) hist[tid] = 0;
        bf16x8 a0[4], a1[4], l0[4], l1[4];
#pragma unroll
        for (int s2 = 0; s2 < 4; ++s2) { const int ko = kb + 32 * s2 + 8 * q4;
            a0[s2] = *(const bf16x8*)(WRH + (size_t)nn * DM + ko); a1[s2] = *(const bf16x8*)(WRH + (size_t)(16 + nn) * DM + ko);
            l0[s2] = *(const bf16x8*)(WRL + (size_t)nn * DM + ko); l1[s2] = *(const bf16x8*)(WRL + (size_t)(16 + nn) * DM + ko); }
#pragma unroll
        for (int half = 0; half < 2; ++half) {
            u32x4 hb[4][4];
#pragma unroll
            for (int g = 0; g < 4; ++g)
#pragma unroll
                for (int s2 = 0; s2 < 4; ++s2) hb[g][s2] = *(const u32x4*)(HB + (size_t)(blk * 128 + 16 * (4 * half + g) + nn) * DM + kb + 32 * s2 + 8 * q4);
#pragma unroll
            for (int g = 0; g < 4; ++g) {
                f32x4 acc0 = {0.f, 0.f, 0.f, 0.f}, acc1 = {0.f, 0.f, 0.f, 0.f}; float ssq = 0.f;
#pragma unroll
                for (int s2 = 0; s2 < 4; ++s2) {
                    const u32x4 hw = hb[g][s2]; const bf16x8 hv = __builtin_bit_cast(bf16x8, hw);
                    const float h0 = bf_lo(hw.x), h1 = bf_hi(hw.x), h2 = bf_lo(hw.y), h3 = bf_hi(hw.y), h4 = bf_lo(hw.z), h5 = bf_hi(hw.z), h6 = bf_lo(hw.w), h7 = bf_hi(hw.w);
                    ssq += ((h0 * h0 + h1 * h1) + (h2 * h2 + h3 * h3)) + ((h4 * h4 + h5 * h5) + (h6 * h6 + h7 * h7));
                    acc0 = __builtin_amdgcn_mfma_f32_16x16x32_bf16(a0[s2], hv, acc0, 0, 0, 0); acc1 = __builtin_amdgcn_mfma_f32_16x16x32_bf16(a1[s2], hv, acc1, 0, 0, 0);
                    acc0 = __builtin_amdgcn_mfma_f32_16x16x32_bf16(l0[s2], hv, acc0, 0, 0, 0); acc1 = __builtin_amdgcn_mfma_f32_16x16x32_bf16(l1[s2], hv, acc1, 0, 0, 0);
                }
                ssq += __shfl_xor(ssq, 16); ssq += __shfl_xor(ssq, 32);
                const int tok = 16 * (4 * half + g) + nn;
                *(LAS f32x4*)(part + tok * 32 + 4 * q4) = acc0; *(LAS f32x4*)(part + tok * 32 + 16 + 4 * q4) = acc1;
                if (q4 == 0) ssqp[tok] = ssq;
            }
        }
        LDS_WAIT();
        __syncthreads();
        const int tl = lane >> 2, pq = lane & 3;
        f32x4 s0 = {0.f, 0.f, 0.f, 0.f}, s1 = {0.f, 0.f, 0.f, 0.f}; float ssq = 0.f;
#pragma unroll
        for (int pw = 0; pw < 8; ++pw) { const LAS float* pp = (const LAS float*)(F.lds + RING_OFF) + pw * 4096 + (16 * wave + tl) * 32 + 8 * pq;
            s0 += *(const LAS f32x4*)pp; s1 += *(const LAS f32x4*)(pp + 4); ssq += ((const LAS float*)(F.lds + EXCH_OFF))[pw * 128 + 16 * wave + tl]; }
        const float r2 = 1.0f / sqrtf(ssq * (1.0f / DM) + NORM_EPS);
        if (pq == 0) R2[t0 + tl] = r2;
        { const f32x4 bq0 = *(const f32x4*)(b_router + 8 * pq), bq1 = *(const f32x4*)(b_router + 8 * pq + 4);
#pragma unroll
          for (int i = 0; i < 4; ++i) { lg[tl * 33 + 8 * pq + i] = s0[i] * r2 + bq0[i]; lg[tl * 33 + 8 * pq + 4 + i] = s1[i] * r2 + bq1[i]; } }
        LDS_WAIT();
        if (lane < 16) {
            float v[32];
#pragma unroll
            for (int e = 0; e < 32; ++e) v[e] = lg[lane * 33 + e];
            int idx[4]; float val[4];
#pragma unroll
            for (int k = 0; k < 4; ++k) {
                float best = -3.0e38f; int bi = 0;
#pragma unroll
                for (int e = 0; e < 32; ++e) { const bool tk = v[e] > best; best = tk ? v[e] : best; bi = tk ? e : bi; }
                idx[k] = bi; val[k] = best;
#pragma unroll
                for (int e = 0; e < 32; ++e) v[e] = (e == bi) ? -3.0e38f : v[e];
            }
            float ex[4], sm = 0.f;
#pragma unroll
            for (int k = 0; k < 4; ++k) { ex[k] = __expf(val[k] - val[0]); sm += ex[k]; }
            const float isum = 1.0f / sm;
#pragma unroll
            for (int k = 0; k < 4; ++k) { selE[lane * 4 + k] = idx[k]; selG[lane * 4 + k] = ex[k] * isum; }
        }
        LDS_WAIT();
        __syncthreads();
        const int myE = selE[lane]; const float myG = selG[lane];
        const int lrank = __hip_atomic_fetch_add(hist + myE, 1, __ATOMIC_RELAXED, __HIP_MEMORY_SCOPE_WORKGROUP);
        __syncthreads();
        if (tid < 32) basee[tid] = (int)__hip_atomic_fetch_add((unsigned*)(ctl + CW_CNT + 64 * tid), (unsigned)hist[tid], RLX_AGENT);
        __syncthreads();
        const int pos = basee[myE] + lrank, pair = (t0 + (lane >> 2)) * 4 + (lane & 3);
        const float myR = r2;
        LISTR[(size_t)myE * T + pos] = (u32x2){(unsigned)pair, __float_as_uint(myR)}; LISTG[(size_t)myE * T + pos] = (u32x2){(unsigned)pair, __float_as_uint(myG)};
        __syncthreads();
    }
    if (!(F.vcu & 1)) { __syncthreads(); convert_experts((const LAS float*)(F.lds + GTAB_OFF), F.lds + RING_OFF, fresh_tid() & 63, wave, F.vcu, F.G); }
    xcd_barrier(bar);

    {
        LAS int* ts = (LAS int*)(F.lds + TS_OFF); LAS int* cn = (LAS int*)(F.lds + CNT_OFF);
        if (threadIdx.x < NE) cn[threadIdx.x] = (int)__hip_atomic_load(ctl + CW_CNT + 64 * threadIdx.x, RLX_AGENT);
        __syncthreads();
        if (threadIdx.x == 0) { int acc = 0; for (int e = 0; e < NE; ++e) { ts[e] = acc; acc += (cn[e] + 255) >> 8; } ts[NE] = acc; }
        __syncthreads();
    }
    const int nMt = __builtin_amdgcn_readfirstlane(((LAS int*)(F.lds + TS_OFF))[NE]);

    for (int rep = 0; rep < REPS(6); ++rep) {
        const KArgs ka = kargs();
        pg8::MoeSched<true> S{KWS(const char, WS_H), KWS(const char, WS_WGU), KWS(const u32x2, WS_LISTR), (LAS const int*)(F.lds + TS_OFF), (LAS const int*)(F.lds + CNT_OFF), 2 * DFF / 256, nMt, F.G, (int)blockIdx.x};
        pg8::EpiGateUp E{KWS(unsigned char, WS_ACT), KIN(14)};
        pg8::gemm_phase<pg8::EpiGateUp, pg8::MoeSched<true>>(F.lds + RING_OFF, S, E);
    }
    xcd_barrier(bar);

    for (int rep = 0; rep < REPS(7); ++rep) {
        const KArgs ka = kargs();
        pg8::MoeSched<false> S{KWS(const char, WS_ACT), KWS(const char, WS_WD), KWS(const u32x2, WS_LISTG), (LAS const int*)(F.lds + TS_OFF), (LAS const int*)(F.lds + CNT_OFF), DM / 256, nMt, F.G, (int)blockIdx.x};
        pg8::EpiDown E{KWS(unsigned char, WS_CONTRIB), KIN(16)};
        pg8::gemm_phase<pg8::EpiDown, pg8::MoeSched<false>>(F.lds + RING_OFF, S, E);
    }
    xcd_barrier(bar);

    {
        const bool bad = (__hip_atomic_load((gu32*)(ctl + CW_BAR) + XB_TMO, RLX_AGENT) != 0u);
        const int lane = fresh_tid() & 63;
        const KArgs ka = kargs();
        const float* const normf_g = KIN(17); const bf16_t* const HB = KWS(bf16_t, WS_HB); const unsigned char* const CONTRIB = KWS(unsigned char, WS_CONTRIB); float* const outp = ka->out;
        f32x4 gn[4];
#pragma unroll
        for (int jh = 0; jh < 2; ++jh) { gn[2 * jh] = *(const f32x4*)(normf_g + jh * 512 + lane * 8); gn[2 * jh + 1] = *(const f32x4*)(normf_g + jh * 512 + lane * 8 + 4); }
        for (int m0 = F.gw; m0 < T; m0 += 2 * F.NGW) {
            u32x4 hw[2][2]; u32x2 cw[2][2][TOPK];
#pragma unroll
            for (int q = 0; q < 2; ++q)
#pragma unroll
                for (int jh = 0; jh < 2; ++jh) { const int m = m0 + q * F.NGW, col = jh * 512 + lane * 8;
                    hw[q][jh] = *(const u32x4*)(HB + (size_t)m * DM + col);
#pragma unroll
                    for (int k = 0; k < TOPK; ++k) cw[q][jh][k] = *(const u32x2*)(CONTRIB + ((size_t)m * TOPK + k) * DM + col); }
#pragma unroll
            for (int q = 0; q < 2; ++q) {
                const int m = m0 + q * F.NGW;
                float v[16];
#pragma unroll
                for (int jh = 0; jh < 2; ++jh) {
                    const u32x4 h4 = hw[q][jh]; float* vv = v + 8 * jh;
                    vv[0] = bf_lo(h4.x); vv[1] = bf_hi(h4.x); vv[2] = bf_lo(h4.y); vv[3] = bf_hi(h4.y); vv[4] = bf_lo(h4.z); vv[5] = bf_hi(h4.z); vv[6] = bf_lo(h4.w); vv[7] = bf_hi(h4.w);
#pragma unroll
                    for (int k = 0; k < TOPK; ++k) { const u32x2 c = cw[q][jh][k];
                        const f32x2 c0 = __builtin_amdgcn_cvt_pk_f32_fp8(c.x, false), c1 = __builtin_amdgcn_cvt_pk_f32_fp8(c.x, true), c2 = __builtin_amdgcn_cvt_pk_f32_fp8(c.y, false), c3 = __builtin_amdgcn_cvt_pk_f32_fp8(c.y, true);
                        vv[0] += c0[0] * 0.0625f; vv[1] += c0[1] * 0.0625f; vv[2] += c1[0] * 0.0625f; vv[3] += c1[1] * 0.0625f; vv[4] += c2[0] * 0.0625f; vv[5] += c2[1] * 0.0625f; vv[6] += c3[0] * 0.0625f; vv[7] += c3[1] * 0.0625f; }
                }
                float sq = 0.f;
#pragma unroll
                for (int k = 0; k < 16; ++k) sq += v[k] * v[k];
                sq = wave_sum(sq);
                float rstd = 1.0f / sqrtf(sq * (1.0f / DM) + NORM_EPS);
                if (bad) rstd = __builtin_nanf("");
#pragma unroll
                for (int jh = 0; jh < 2; ++jh) {
                    const int col = jh * 512 + lane * 8; const float* vv = v + 8 * jh; const f32x4 g0 = gn[2 * jh], g1 = gn[2 * jh + 1];
                    *(f32x4*)(outp + (size_t)m * DM + col) = (f32x4){vv[0] * rstd * g0[0], vv[1] * rstd * g0[1], vv[2] * rstd * g0[2], vv[3] * rstd * g0[3]};
                    *(f32x4*)(outp + (size_t)m * DM + col + 4) = (f32x4){vv[4] * rstd * g1[0], vv[5] * rstd * g1[1], vv[6] * rstd * g1[2], vv[7] * rstd * g1[3]};
                }
            }
        }
    }
}

extern "C" void kernel_launch(void* const* d_in, const int* in_sizes, int n_in, void* d_out, int out_size, void* d_ws, size_t ws_size, hipStream_t stream) {
    static int grid = 0;
    if (grid == 0) {
        if (n_in != 18 || in_sizes[0] != T * DM || out_size != T * DM || ws_size < WS_END) { fprintf(stderr, "kernel_launch: unexpected shapes (n_in %d, ws %zu)\n", n_in, ws_size); grid = -1; return; }
        int dev = 0, cus = 0, per_cu = 0;
        if (hipGetDevice(&dev) != hipSuccess || hipDeviceGetAttribute(&cus, hipDeviceAttributeMultiprocessorCount, dev) != hipSuccess) { grid = -1; return; }
        if (hipFuncSetAttribute((const void*)fwd_kernel, hipFuncAttributeMaxDynamicSharedMemorySize, LDS_BYTES) != hipSuccess) { fprintf(stderr, "kernel_launch: hipFuncSetAttribute failed\n"); grid = -1; return; }
        if (hipOccupancyMaxActiveBlocksPerMultiprocessor(&per_cu, (const void*)fwd_kernel, 512, LDS_BYTES) != hipSuccess || per_cu < 1) { fprintf(stderr, "kernel_launch: occupancy query says %d\n", per_cu); }
        (void)hipGetLastError();
        grid = cus;
    }
    if (grid < 0) return;
    (void)hipMemsetAsync((char*)d_ws + WS_CTL, 0, CTL_ZERO_BYTES, stream);
    Args a{};
    for (int i = 0; i < 18; ++i) a.in[i] = (const float*)d_in[i];
    a.out = (float*)d_out; a.ws = (unsigned char*)d_ws;
    hipLaunchKernelGGL(fwd_kernel, dim3(grid), dim3(512), LDS_BYTES, stream, a);
}
```

```cpp
#include <hip/hip_runtime.h>
#include <cstdio>
#include <cstdint>

#define LAS __attribute__((address_space(3)))
#define GAS __attribute__((address_space(1)))
typedef unsigned short bf16_t;
typedef short bf16x8 __attribute__((ext_vector_type(8)));
typedef short s16x4 __attribute__((ext_vector_type(4)));
typedef float f32x2 __attribute__((ext_vector_type(2)));
typedef float f32x4 __attribute__((ext_vector_type(4)));
typedef float f32x16 __attribute__((ext_vector_type(16)));
typedef unsigned u32x2 __attribute__((ext_vector_type(2)));
typedef unsigned u32x4 __attribute__((ext_vector_type(4)));
typedef GAS unsigned gu32;
typedef int v8i __attribute__((ext_vector_type(8)));

constexpr int BATCH = 16, SEQ = 2048, DM = 1024, T = BATCH * SEQ, HD = 64, NH = 8, AW = 512, INW = 2560;
constexpr int NE = 32, TOPK = 4, DFF = 1024, CHUNK = 128;
constexpr float NORM_EPS = 1e-5f;
constexpr float QSCALE = 0.125f * 1.4426950408889634f;

constexpr size_t MiB = 1u << 20, KiB = 1u << 10;
constexpr size_t WS_CTL = 0, CTL_ZERO_BYTES = 64 * KiB;
constexpr size_t WS_WRT = 1 * MiB, WS_WSB = 1 * MiB + 256 * KiB, WS_COS = 2 * MiB, WS_SIN = 2 * MiB + 256 * KiB;
constexpr size_t WS_R1 = 3 * MiB, WS_R2 = 3 * MiB + 128 * KiB, WS_LSE = 8 * MiB;
constexpr size_t WS_WIN = 16 * MiB, WS_WOUT = 22 * MiB, WS_WGU = 24 * MiB, WS_WD = 152 * MiB, WS_H = 216 * MiB, WS_HB = 344 * MiB;
constexpr size_t WS_ACT = 408 * MiB, WS_XB = 408 * MiB, WS_U = 472 * MiB, WS_VN = 504 * MiB, WS_Q = 536 * MiB, WS_K = 568 * MiB, WS_V = 600 * MiB;
constexpr size_t WS_CONTRIB = 680 * MiB, WS_MIXED = 680 * MiB, WS_BPART = 744 * MiB, WS_LISTR = 936 * MiB, WS_LISTG = 944 * MiB, WS_END = 953 * MiB;
constexpr int CW_TMO = 0, CW_CNT = 8192, CW_BAR = 4096;

constexpr int RING_OFF = 0, RING_BYTES = 131072;
constexpr int LDSCTL_OFF = RING_BYTES;
constexpr int TS_OFF = LDSCTL_OFF, CNT_OFF = LDSCTL_OFF + 256, MISC_OFF = LDSCTL_OFF + 512, HIST_OFF = LDSCTL_OFF + 640, EXCH_OFF = LDSCTL_OFF + 1024, META_OFF = LDSCTL_OFF + 5120;
constexpr int OST_OFF = META_OFF + 6144;
constexpr int GTAB_OFF = OST_OFF + 16384;
constexpr int LDS_BYTES = 163840;
static_assert(EXCH_OFF + 4096 <= META_OFF && GTAB_OFF + 4608 <= LDS_BYTES && 8 * 2816 <= 6144 + 16384, "LDS map");

#define LDS_WAIT() asm volatile("s_waitcnt lgkmcnt(0)" ::: "memory")
#define VM_WAIT() asm volatile("s_waitcnt vmcnt(0)" ::: "memory")
#define RLX_AGENT __ATOMIC_RELAXED, __HIP_MEMORY_SCOPE_AGENT

__device__ __forceinline__ unsigned cvt_pk_bf16(float lo, float hi) { unsigned r; asm volatile("v_cvt_pk_bf16_f32 %0, %1, %2" : "=v"(r) : "v"(lo), "v"(hi)); return r; }
__device__ __forceinline__ unsigned pk4_fp8(float a, float b, float c, float d) { unsigned w = 0; w = __builtin_amdgcn_cvt_pk_fp8_f32(a, b, w, false); w = __builtin_amdgcn_cvt_pk_fp8_f32(c, d, w, true); return w; }
__device__ __forceinline__ float bf_lo(unsigned w) { return __uint_as_float(w << 16); }
__device__ __forceinline__ float bf_hi(unsigned w) { return __uint_as_float(w & 0xffff0000u); }
__device__ __forceinline__ float wave_sum(float v) {
#pragma unroll
    for (int o = 1; o < 64; o <<= 1) v += __shfl_xor(v, o);
    return v;
}
__device__ __forceinline__ float gelu_tanh(float x) {
    const float u = x * (1.0f + 0.044715f * x * x);
    const float e = __builtin_amdgcn_exp2f(-2.3022081981f * u);
    return x * __builtin_amdgcn_rcpf(1.0f + e);
}

__device__ __forceinline__ int fresh_tid() { int t = threadIdx.x; asm volatile("" : "+v"(t)); return t; }
#define XB_TMO      128
#define XB_XCNT(j)  (256  + 64 * (j))
#define XB_XSUB(j)  (1280 + 64 * (j))
#define XB_XGEN(j)  (2304 + 64 * (j))
#define XB_TOP      3328
#define XB_TOPGEN   3392
#define XCD_BAR_WORDS 3456
#define XB_SPIN_CAP (1u << 18)
__device__ __forceinline__ unsigned xb_ld(unsigned* p)              { return __hip_atomic_load(p, __ATOMIC_RELAXED, __HIP_MEMORY_SCOPE_AGENT); }
__device__ __forceinline__ unsigned xb_add(unsigned* p, unsigned v) { return __hip_atomic_fetch_add(p, v, __ATOMIC_RELAXED, __HIP_MEMORY_SCOPE_AGENT); }
__device__ __forceinline__ unsigned xb_xcc_id() { return (unsigned)__builtin_amdgcn_s_getreg((3 << 11) | 20) & 0xFu; }
#define XB_SPIN(cond, bar) do { unsigned _sp = 0; while (cond) { __builtin_amdgcn_s_sleep(1); \
    if ((++_sp & 255u) == 0u) { if (xb_ld(&(bar)[XB_TMO])) break; if (_sp > XB_SPIN_CAP) { atomicAdd(&(bar)[XB_TMO], 1u); break; } } } } while (0)
struct XcdBarrier { unsigned* bar; unsigned x; volatile LAS unsigned* st; };
__device__ __forceinline__ XcdBarrier xcd_barrier_post(unsigned* bar, volatile LAS unsigned* st) {
    XcdBarrier b; b.bar = bar; b.x = xb_xcc_id(); b.st = st;
    if (threadIdx.x == 0) (void)xb_add(&bar[XB_XCNT(b.x)], 1u);
    return b;
}
__device__ __forceinline__ void xcd_barrier_complete(unsigned* bar, unsigned x, unsigned& nloc, unsigned& nx) {
    const unsigned G = gridDim.x * gridDim.y * gridDim.z;
    unsigned sum, cnt, mine, sp = 0u;
    for (;;) {
        sum = 0u; cnt = 0u; mine = 0u;
#pragma unroll
        for (unsigned j = 0; j < 16; ++j) { const unsigned c = xb_ld(&bar[XB_XCNT(j)]); sum += c; cnt += (c > 0u) ? 1u : 0u; mine = (j == x) ? c : mine; }
        if (sum == G) break;
        __builtin_amdgcn_s_sleep(1);
        if ((++sp & 255u) == 0u) { if (xb_ld(&bar[XB_TMO])) break; if (sp > XB_SPIN_CAP) { atomicAdd(&bar[XB_TMO], 1u); break; } }
    }
    nloc = mine > 0u ? mine : 1u; nx = cnt > 0u ? cnt : 1u;
}
__device__ __forceinline__ void xcd_barrier(const XcdBarrier& b) {
    asm volatile("s_waitcnt vmcnt(0)" ::: "memory");
    __syncthreads();
    if (threadIdx.x == 0) {
        unsigned* bar = b.bar;
        const unsigned bx = xb_xcc_id();
        __builtin_amdgcn_s_waitcnt(0);
        unsigned nloc = b.st[0], nx = b.st[1];
        if (nloc == 0u) { xcd_barrier_complete(bar, bx, nloc, nx); b.st[0] = nloc; b.st[1] = nx; }
        const unsigned old = xb_add(&bar[XB_XSUB(bx)], 1u);
        const unsigned gen = old / nloc;
        if (old + 1u == (gen + 1u) * nloc) {
            __builtin_amdgcn_fence(__ATOMIC_RELEASE, "agent");
            asm volatile("s_waitcnt vmcnt(0)" ::: "memory");
            const unsigned og = xb_add(&bar[XB_TOP], 1u);
            const unsigned tg = og / nx;
            if (og + 1u == (tg + 1u) * nx) xb_add(&bar[XB_TOPGEN], 1u);
            else XB_SPIN(xb_ld(&bar[XB_TOPGEN]) == tg, bar);
            __builtin_amdgcn_fence(__ATOMIC_ACQUIRE, "agent");
            xb_add(&bar[XB_XGEN(bx)], 1u);
            asm volatile("s_waitcnt vmcnt(0)" ::: "memory");
        } else {
            XB_SPIN(xb_ld(&bar[XB_XGEN(bx)]) == gen, bar);
            __builtin_amdgcn_fence(__ATOMIC_ACQUIRE, "agent");
            asm volatile("s_waitcnt vmcnt(0)" ::: "memory");
        }
    }
    __syncthreads();
}

__device__ __forceinline__ size_t kv_off(int b, int head, int t) { return ((size_t)((b * NH + head) * SEQ + ((t & 15) << 7) + (t >> 4))) * HD; }
namespace pg8 {
constexpr int BM = 256, BK = 64, HALF = 128, HTB = HALF * BK * 2, NXCD = 8, WGM = 8, KD = 1024;
__device__ __forceinline__ int lds_byte(int r, int c) { const int st = (r >> 4) * 2 + (c >> 5), rr = r & 15, cc = c & 31, ob = rr * 64 + cc * 2; return st * 1024 + (ob ^ (((ob >> 9) & 1) << 5)); }
__device__ __forceinline__ void stage_rc(int b, int& R, int& C) { const int st = b / 1024, sb = b % 1024, swz = sb ^ (((sb >> 9) & 1) << 5); R = (st >> 1) * 16 + swz / 64; C = (st & 1) * 32 + (swz % 64) / 2; }
__device__ __forceinline__ int perm32(int rho) { const int n = rho >> 4, i = rho & 15; return 8 * (i >> 2) + 4 * n + (i & 3); }

struct Unit { int pm, pn, e, lrow0, nvalid; };
typedef int v4i __attribute__((ext_vector_type(4)));
__device__ __forceinline__ v8i ld_frag(const LAS unsigned char* p) { const v4i lo = *(const LAS v4i*)p, hi = *(const LAS v4i*)(p + 1024); return __builtin_shufflevector(lo, hi, 0, 1, 2, 3, 4, 5, 6, 7); }
__device__ __forceinline__ bf16x8 frag_k(const v8i f, int k) { const v4i h = k ? __builtin_shufflevector(f, f, 4, 5, 6, 7) : __builtin_shufflevector(f, f, 0, 1, 2, 3); return __builtin_bit_cast(bf16x8, h); }

__device__ __forceinline__ bool tile_of(int L, int nM, int nN, int& pm, int& pn, const int WGM = 8) {
    const int nwg = nM * nN; if (L >= nwg) return false;
    int wgid = L; { const int q = nwg / NXCD, r = nwg % NXCD, xcd = wgid % NXCD, off = wgid / NXCD; wgid = (xcd < r ? xcd * (q + 1) : r * (q + 1) + (xcd - r) * q) + off; }
    const int nig = WGM * nN, gid = wgid / nig, fm = gid * WGM, gsz = (nM - fm) < WGM ? (nM - fm) : WGM;
    pm = fm + ((wgid % nig) % gsz); pn = (wgid % nig) / gsz; return true;
}
struct DenseSched {
    static constexpr bool HAS_META = false; static constexpr int RB = KD * 2, BMAP = 0, RBB = RB, KSB = BK * 2, KSA = BK * 2;
    const char* A; const char* Bt; int nM, nN, G, c;
    __device__ __forceinline__ const char* meta_src(const Unit&) const { return nullptr; }
    __device__ __forceinline__ void a_offs_meta(const Unit& u, const LAS unsigned char*, const int (&R)[2], const int (&C)[2], unsigned (&o)[2][2]) const { a_offs(u, R, C, o); }
    __device__ __forceinline__ bool next(int i, Unit& u) const { u.e = 0; u.lrow0 = 0; u.nvalid = 256; return tile_of(i * G + c, nM, nN, u.pm, u.pn); }
    __device__ __forceinline__ const char* a_base() const { return A; }
    __device__ __forceinline__ void a_offs(const Unit& u, const int (&R)[2], const int (&C)[2], unsigned (&o)[2][2]) const {
#pragma unroll
        for (int h = 0; h < 2; ++h)
#pragma unroll
            for (int i = 0; i < 2; ++i) o[h][i] = (unsigned)((u.pm * BM + h * HALF + R[i]) * KD + C[i]) * 2u;
    }
    __device__ __forceinline__ const char* b_tile(const Unit& u) const { return Bt + (size_t)u.pn * (BM * KD * 2); }
};
template <bool GATHER>
struct MoeSched {
    static constexpr bool HAS_META = true; static constexpr int RB = KD, BMAP = GATHER ? 0 : 1, RBB = 128, KSB = 256 * 128, KSA = GATHER ? BK * 2 : 256 * 128;
    const char* A; const char* Bt; const u32x2* list; LAS const int* ts; LAS const int* cnt; int nN, nM, G, c; LAS const int* utab;
    __device__ __forceinline__ bool next(int i, Unit& u) const {
        const v4i q = *(const LAS v4i*)(utab + 8 * i); const int w4 = utab[8 * i + 4];
        u.pm = __builtin_amdgcn_readfirstlane(q[0]); u.pn = __builtin_amdgcn_readfirstlane(q[1]); u.e = __builtin_amdgcn_readfirstlane(q[2]); u.lrow0 = __builtin_amdgcn_readfirstlane(q[3]);
        const int nv = __builtin_amdgcn_readfirstlane(w4); u.nvalid = nv; return nv > 0;
    }
    __device__ __forceinline__ void build_table(LAS int* tab, int t) const {
        Unit u; const bool ok = search(t, u);
        tab[8 * t] = u.pm; tab[8 * t + 1] = u.pn; tab[8 * t + 2] = u.e; tab[8 * t + 3] = u.lrow0; tab[8 * t + 4] = ok ? u.nvalid : 0;
    }
    __device__ __forceinline__ bool search(int i, Unit& u) const {
        u.pm = 0; u.pn = 0; u.e = 0; u.lrow0 = 0; u.nvalid = 0;
        if (!tile_of(i * G + c, nM, nN, u.pm, u.pn, GATHER ? 4 : 8)) return false;
        int e = 0;
#pragma unroll
        for (int s = 16; s >= 1; s >>= 1) { const int v = ts[e + s]; if (v <= u.pm) e += s; }
        const int t0 = ts[e], ce = cnt[e];
        u.e = e; u.lrow0 = (u.pm - t0) * BM; const int rem = ce - u.lrow0; u.nvalid = rem < BM ? rem : BM; return true;
    }
    __device__ __forceinline__ const char* a_base() const { return A; }
    __device__ __forceinline__ const char* meta_src(const Unit& u) const { return (const char*)(list + (size_t)u.e * T + u.lrow0); }
    __device__ __forceinline__ void a_offs(const Unit& u, const int (&R)[2], const int (&C)[2], unsigned (&o)[2][2]) const {
#pragma unroll
        for (int h = 0; h < 2; ++h)
#pragma unroll
            for (int i = 0; i < 2; ++i) {
                if (GATHER) { int lr = h * HALF + R[i]; lr = lr < u.nvalid ? lr : 0; const unsigned v = list[(size_t)u.e * T + u.lrow0 + lr].x; o[h][i] = (unsigned)((int)(v >> 2) * RB + C[i] * 2); }
                else o[h][i] = (unsigned)(u.pm * (8 * 32768) + (h * HALF + R[i]) * 128 + C[i] * 2);
            }
    }
    __device__ __forceinline__ void a_offs_meta(const Unit& u, const LAS unsigned char* meta, const int (&R)[2], const int (&C)[2], unsigned (&o)[2][2]) const {
#pragma unroll
        for (int h = 0; h < 2; ++h)
#pragma unroll
            for (int i = 0; i < 2; ++i) {
                if (GATHER) { int lr = h * HALF + R[i]; lr = lr < u.nvalid ? lr : 0; const unsigned v = *(const LAS unsigned*)(meta + lr * 8); o[h][i] = (unsigned)((int)(v >> 2) * RB + C[i] * 2); }
                else o[h][i] = (unsigned)(u.pm * (8 * 32768) + (h * HALF + R[i]) * 128 + C[i] * 2);
            }
    }
    __device__ __forceinline__ const char* b_tile(const Unit& u) const { return Bt + ((size_t)u.e * nN + u.pn) * (size_t)(BM * RB); }
};

template <class Epi, class Sched>
__device__ __forceinline__ void gemm_phase(LAS unsigned char* lds, const Sched& S, const Epi& E) {
    constexpr int RB = Sched::RB, nt = RB / (BK * 2);
    constexpr bool F8 = (RB == KD);
    const int tid = fresh_tid(), wid = __builtin_amdgcn_readfirstlane(tid >> 6), lane = tid & 63, wr = wid >> 2, wc = wid & 3, fr = lane & 15, fq = lane >> 4;
    int R[2], C[2]; unsigned voffB[2];
#pragma unroll
    for (int i = 0; i < 2; ++i) { stage_rc(tid * 16 + i * 8192, R[i], C[i]); const int rho = R[i] & 31;
        const int Rb = Sched::BMAP == 0 ? (R[i] & ~31) + perm32(rho) : 64 * (R[i] >> 5) + 16 * ((rho & 15) >> 2) + 4 * (rho >> 4) + (rho & 3);
        voffB[i] = (unsigned)(Rb * Sched::RBB + C[i] * 2); }
    constexpr size_t kstep = (size_t)Sched::KSA, kstepB = (size_t)Sched::KSB;
    constexpr size_t hstepB = (size_t)(Sched::BMAP == 0 ? HALF : 8) * Sched::RBB;
    const unsigned ldsw = (unsigned)wid * 1024u;
    const int aoff = lds_byte(wr * 64 + fr, fq * 8), boff = lds_byte(wc * 32 + fr, fq * 8);
#define PG8_SA(b, h) (((b) * 2 + (h)) * HTB)
#define PG8_SB(b, h) ((4 + (b) * 2 + (h)) * HTB)
#define PG8_STAGE_B(bufoff, gbase) do { _Pragma("unroll") for (int _i = 0; _i < 2; ++_i) \
        __builtin_amdgcn_global_load_lds((const unsigned*)((const char*)(gbase) + voffB[_i]), (LAS unsigned*)(lds + (bufoff) + ldsw + _i * 8192), 16, 0, 0); } while (0)
#define PG8_STAGE_A(bufoff, kb, off, h) do { _Pragma("unroll") for (int _i = 0; _i < 2; ++_i) \
        __builtin_amdgcn_global_load_lds((const unsigned*)(Ab + (kb) + (off)[h][_i]), (LAS unsigned*)(lds + (bufoff) + ldsw + _i * 8192), 16, 0, 0); } while (0)
#define PG8_LDA(dst, b, h) do { _Pragma("unroll") for (int m = 0; m < 4; ++m) dst[m] = ld_frag(lds + PG8_SA(b, h) + aoff + m * 2048); } while (0)
#define PG8_LDB(dst, b, h) do { _Pragma("unroll") for (int n = 0; n < 2; ++n) dst[n] = ld_frag(lds + PG8_SB(b, h) + boff + n * 2048); } while (0)
#define PG8_MMA(ai, bj, At, Bt) do { __builtin_amdgcn_s_setprio(1); _Pragma("unroll") for (int m = 0; m < 4; ++m) _Pragma("unroll") for (int n = 0; n < 2; ++n) { \
        if constexpr (F8) { acc[ai][bj][m][n] = __builtin_amdgcn_mfma_scale_f32_16x16x128_f8f6f4(Bt[n], At[m], acc[ai][bj][m][n], 0, 0, 0, 0x7F7F7F7F, 0, 0x7F7F7F7F); } \
        else { _Pragma("unroll") for (int k = 0; k < 2; ++k) acc[ai][bj][m][n] = __builtin_amdgcn_mfma_f32_16x16x32_bf16(frag_k(Bt[n], k), frag_k(At[m], k), acc[ai][bj][m][n], 0, 0, 0); } } \
        __builtin_amdgcn_s_setprio(0); } while (0)
#define PG8_META(slot) (lds + (META_OFF - RING_OFF) + (slot) * 2048)
#define PG8_META_DMA(slot, src) do { if (Sched::HAS_META && wid == 0) { _Pragma("unroll") for (int _i = 0; _i < 2; ++_i) \
        __builtin_amdgcn_global_load_lds((const unsigned*)((const char*)(src) + (unsigned)((fresh_tid() & 63) * 16 + _i * 1024)), (LAS unsigned*)(PG8_META(slot) + _i * 1024), 16, 0, 0); } } while (0)
#define PG8_WAIT_V(n) asm volatile("s_waitcnt vmcnt(" #n ")" ::: "memory")
#define PG8_WAIT_L(n) asm volatile("s_waitcnt lgkmcnt(" #n ")" ::: "memory")
#define PG8_BAR __builtin_amdgcn_s_barrier()
#define PG8_SCHED __builtin_amdgcn_sched_barrier(0)
    Unit cur, nxt; int ui = 0, sc = 0;
    if (!S.next(0, cur)) return;
    f32x4 acc[2][2][4][2];
#pragma unroll
    for (int a = 0; a < 2; ++a)
#pragma unroll
        for (int b = 0; b < 2; ++b)
#pragma unroll
            for (int m = 0; m < 4; ++m)
#pragma unroll
                for (int n = 0; n < 2; ++n) acc[a][b][m][n] = (f32x4){0.f, 0.f, 0.f, 0.f};
    v8i At[4], B0[2], B1[2];
    unsigned co[2][2];
    S.a_offs(cur, R, C, co);
    const char* const Ab = S.a_base();
    const char* cB = S.b_tile(cur);
    PG8_META_DMA(0, S.meta_src(cur));
    PG8_STAGE_B(PG8_SB(0, 0), cB); PG8_STAGE_B(PG8_SB(0, 1), cB + hstepB); PG8_STAGE_A(PG8_SA(0, 0), 0, co, 0); PG8_STAGE_A(PG8_SA(0, 1), 0, co, 1);
    if (wr == 1) PG8_BAR;
    PG8_WAIT_V(2); PG8_BAR;
    PG8_STAGE_B(PG8_SB(1, 0), cB + kstepB); PG8_STAGE_A(PG8_SA(1, 0), kstep, co, 0); PG8_STAGE_B(PG8_SB(1, 1), cB + hstepB + kstepB);
    PG8_WAIT_V(6); PG8_BAR;
    for (;;) {
        const bool has_next = S.next(ui + 1, nxt);
        const char* nB = cB;
        const int sn = (sc == 2) ? 0 : sc + 1;
        if (has_next) { nB = S.b_tile(nxt); PG8_META_DMA(sn, S.meta_src(nxt)); }
#pragma nounroll
        for (int t = 0; t < nt; t += 2) {
            const bool last = (t == nt - 2);
            const size_t k1 = (size_t)(t + 1) * kstep;
            const size_t k2 = last ? (size_t)0 : (size_t)(t + 2) * kstep; const char* b2 = last ? nB : cB + (size_t)(t + 2) * kstepB;
            const size_t k3 = k2 + kstep; const char* b3 = b2 + kstepB;
            PG8_LDB(B0, 0, 0); PG8_LDB(B1, 0, 1); PG8_SCHED; PG8_LDA(At, 0, 0); PG8_STAGE_A(PG8_SA(1, 1), k1, co, 1);
            PG8_WAIT_V(8); PG8_WAIT_L(0); PG8_BAR; PG8_MMA(0, 0, At, B0); PG8_MMA(0, 1, At, B1); PG8_BAR; PG8_SCHED;
            if (last && has_next) {
                int R2[2], C2[2]; const int t2 = fresh_tid();
#pragma unroll
                for (int i = 0; i < 2; ++i) stage_rc(t2 * 16 + i * 8192, R2[i], C2[i]);
                S.a_offs_meta(nxt, PG8_META(sn), R2, C2, co);
            }
            PG8_LDA(At, 0, 1); PG8_STAGE_B(PG8_SB(0, 0), b2); PG8_STAGE_B(PG8_SB(0, 1), b2 + hstepB); PG8_STAGE_A(PG8_SA(0, 0), k2, co, 0);
            PG8_WAIT_V(8); PG8_WAIT_L(0); PG8_BAR; PG8_MMA(1, 0, At, B0); PG8_MMA(1, 1, At, B1); PG8_BAR; PG8_SCHED;
            PG8_LDB(B0, 1, 0); PG8_LDB(B1, 1, 1); PG8_SCHED; PG8_LDA(At, 1, 0); PG8_STAGE_A(PG8_SA(0, 1), k2, co, 1);
            PG8_WAIT_V(8); PG8_WAIT_L(0); PG8_BAR; PG8_MMA(0, 0, At, B0); PG8_MMA(0, 1, At, B1); PG8_BAR; PG8_SCHED;
            PG8_LDA(At, 1, 1); PG8_STAGE_B(PG8_SB(1, 0), b3); PG8_STAGE_B(PG8_SB(1, 1), b3 + hstepB); PG8_STAGE_A(PG8_SA(1, 0), k3, co, 0);
            PG8_WAIT_V(8); PG8_WAIT_L(0); PG8_BAR; PG8_MMA(1, 0, At, B0); PG8_MMA(1, 1, At, B1); PG8_BAR; PG8_SCHED;
        }
        if (wr == 0) PG8_BAR;
        E(acc, cur, wr, wc, fr, fq, PG8_META(sc));
        if (!has_next) break;
#pragma unroll
        for (int a = 0; a < 2; ++a)
#pragma unroll
            for (int b = 0; b < 2; ++b)
#pragma unroll
                for (int m = 0; m < 4; ++m)
#pragma unroll
                    for (int n = 0; n < 2; ++n) acc[a][b][m][n] = (f32x4){0.f, 0.f, 0.f, 0.f};
        cur = nxt; cB = nB; ++ui; sc = sn;
        if (wr == 1) PG8_BAR;
    }
    PG8_WAIT_V(0);
    PG8_BAR;
#undef PG8_SA
#undef PG8_SB
#undef PG8_STAGE_A
#undef PG8_STAGE_B
#undef PG8_META
#undef PG8_META_DMA
#undef PG8_LDA
#undef PG8_LDB
#undef PG8_MMA
#undef PG8_WAIT_V
#undef PG8_WAIT_L
#undef PG8_BAR
#undef PG8_SCHED
}

__device__ __forceinline__ void store_bf16x8(bf16_t* p, const f32x4 a, const f32x4 b) {
    u32x4 w; w.x = cvt_pk_bf16(a[0], a[1]); w.y = cvt_pk_bf16(a[2], a[3]); w.z = cvt_pk_bf16(b[0], b[1]); w.w = cvt_pk_bf16(b[2], b[3]);
    *(u32x4*)p = w;
}

struct EpiProj {
    bf16_t *U, *VN, *Q, *KK, *V; const float *R1, *cosT, *sinT, *lng, *lnb;
    __device__ __forceinline__ void operator()(const f32x4 (&acc)[2][2][4][2], const Unit& u, int wr, int wc, int fr, int fq, const LAS unsigned char* meta) const {
        const int type = u.pn >> 1, head = (u.pn & 1) * 4 + wc, colb = head * HD + 8 * fq;
        const int row0 = u.pm * BM + wr * 64 + fr;
        float rsv[8];
#pragma unroll
        for (int k = 0; k < 8; ++k) rsv[k] = R1[row0 + (k >> 2) * HALF + (k & 3) * 16];
        if (type == 0 || type == 4) {
            bf16_t* const dst = type == 0 ? U : V;
#pragma unroll
            for (int k = 0; k < 8; ++k) { const int ai = k >> 2, m = k & 3; const float rs = rsv[k];
                f32x4 x00 = acc[ai][0][m][0] * rs, x01 = acc[ai][0][m][1] * rs, x10 = acc[ai][1][m][0] * rs, x11 = acc[ai][1][m][1] * rs;
                if (type == 0) {
#pragma unroll
                    for (int j = 0; j < 4; ++j) { x00[j] = gelu_tanh(x00[j]); x01[j] = gelu_tanh(x01[j]); x10[j] = gelu_tanh(x10[j]); x11[j] = gelu_tanh(x11[j]); } }
                const int row = row0 + ai * HALF + m * 16;
                bf16_t* rp = type == 0 ? dst + (size_t)row * AW + colb : dst + kv_off(row >> 11, head, row & (SEQ - 1)) + 8 * fq;
                store_bf16x8(rp, x00, x01); store_bf16x8(rp + 32, x10, x11); }
        } else if (type == 1) {
            const float* gp = lng + colb; const float* bp = lnb + colb;
            const f32x4 lg0 = *(const f32x4*)(gp), lg1 = *(const f32x4*)(gp + 4), lg2 = *(const f32x4*)(gp + 32), lg3 = *(const f32x4*)(gp + 36);
            const f32x4 lb0 = *(const f32x4*)(bp), lb1 = *(const f32x4*)(bp + 4), lb2 = *(const f32x4*)(bp + 32), lb3 = *(const f32x4*)(bp + 36);
#pragma unroll
            for (int k = 0; k < 8; ++k) { const int ai = k >> 2, m = k & 3; const float rs = rsv[k];
                f32x4 x00 = acc[ai][0][m][0] * rs, x01 = acc[ai][0][m][1] * rs, x10 = acc[ai][1][m][0] * rs, x11 = acc[ai][1][m][1] * rs;
#pragma unroll
                for (int j = 0; j < 4; ++j) { x00[j] = gelu_tanh(x00[j]); x01[j] = gelu_tanh(x01[j]); x10[j] = gelu_tanh(x10[j]); x11[j] = gelu_tanh(x11[j]); }
                float sm = 0.f;
#pragma unroll
                for (int j = 0; j < 4; ++j) sm += (x00[j] + x01[j]) + (x10[j] + x11[j]);
                sm += __shfl_xor(sm, 16); sm += __shfl_xor(sm, 32);
                const float mu = sm * (1.0f / 64.0f);
                x00 -= mu; x01 -= mu; x10 -= mu; x11 -= mu;
                float q = 0.f;
#pragma unroll
                for (int j = 0; j < 4; ++j) q += (x00[j] * x00[j] + x01[j] * x01[j]) + (x10[j] * x10[j] + x11[j] * x11[j]);
                q += __shfl_xor(q, 16); q += __shfl_xor(q, 32);
                const float rstd = 1.0f / sqrtf(q * (1.0f / 64.0f) + NORM_EPS);
                x00 = x00 * rstd * lg0 + lb0; x01 = x01 * rstd * lg1 + lb1; x10 = x10 * rstd * lg2 + lb2; x11 = x11 * rstd * lg3 + lb3;
                bf16_t* rp = VN + (size_t)(row0 + ai * HALF + m * 16) * AW + colb;
                store_bf16x8(rp, x00, x01); store_bf16x8(rp + 32, x10, x11); }
        } else {
            bf16_t* const dst = type == 2 ? Q : KK; const float sc = type == 2 ? QSCALE : 1.0f;
#pragma unroll
            for (int kp = 0; kp < 4; ++kp) {
                f32x4 tc0[2], tc1[2], ts0[2], ts1[2];
#pragma unroll
                for (int mm = 0; mm < 2; ++mm) { const int k = 2 * kp + mm, pos = (row0 + (k >> 2) * HALF + (k & 3) * 16) & (SEQ - 1);
                    tc0[mm] = *(const f32x4*)(cosT + pos * 32 + 8 * fq); tc1[mm] = *(const f32x4*)(cosT + pos * 32 + 8 * fq + 4); ts0[mm] = *(const f32x4*)(sinT + pos * 32 + 8 * fq); ts1[mm] = *(const f32x4*)(sinT + pos * 32 + 8 * fq + 4); }
#pragma unroll
                for (int mm = 0; mm < 2; ++mm) { const int k = 2 * kp + mm, ai = k >> 2, m = k & 3; const float rs = rsv[k] * sc;
                    const f32x4 x00 = acc[ai][0][m][0] * rs, x01 = acc[ai][0][m][1] * rs, x10 = acc[ai][1][m][0] * rs, x11 = acc[ai][1][m][1] * rs;
                    const f32x4 o00 = x00 * tc0[mm] - x10 * ts0[mm], o01 = x01 * tc1[mm] - x11 * ts1[mm], o10 = x10 * tc0[mm] + x00 * ts0[mm], o11 = x11 * tc1[mm] + x01 * ts1[mm];
                    const int row = row0 + ai * HALF + m * 16;
                    bf16_t* rp = dst + kv_off(row >> 11, head, row & (SEQ - 1)) + 8 * fq;
                    store_bf16x8(rp, o00, o01); store_bf16x8(rp + 32, o10, o11); }
            }
        }
    }
};
struct EpiOut {
    const bf16_t* x; bf16_t* HB; unsigned char* H8;
    __device__ __forceinline__ void operator()(const f32x4 (&acc)[2][2][4][2], const Unit& u, int wr, int wc, int fr, int fq, const LAS unsigned char* meta) const {
        const int row0 = u.pm * BM + wr * 64 + fr, col0 = u.pn * BM + wc * 32 + 8 * fq;
        u32x4 xw[2][4][2];
#pragma unroll
        for (int ai = 0; ai < 2; ++ai)
#pragma unroll
            for (int m = 0; m < 4; ++m)
#pragma unroll
                for (int bj = 0; bj < 2; ++bj) xw[ai][m][bj] = *(const u32x4*)(x + (size_t)(row0 + ai * HALF + m * 16) * DM + col0 + bj * HALF);
#pragma unroll
        for (int ai = 0; ai < 2; ++ai)
#pragma unroll
            for (int m = 0; m < 4; ++m) {
                const size_t off = (size_t)(row0 + ai * HALF + m * 16) * DM + col0;
#pragma unroll
                for (int bj = 0; bj < 2; ++bj) {
                    const u32x4 q = xw[ai][m][bj];
                    const f32x4 h0 = (f32x4){bf_lo(q.x), bf_hi(q.x), bf_lo(q.y), bf_hi(q.y)} + acc[ai][bj][m][0], h1 = (f32x4){bf_lo(q.z), bf_hi(q.z), bf_lo(q.w), bf_hi(q.w)} + acc[ai][bj][m][1];
                    store_bf16x8(HB + off + bj * HALF, h0, h1);
                    u32x2 w8; w8.x = pk4_fp8(h0[0], h0[1], h0[2], h0[3]); w8.y = pk4_fp8(h1[0], h1[1], h1[2], h1[3]);
                    *(u32x2*)(H8 + off + bj * HALF) = w8;
                }
            }
    }
};
struct EpiGateUp {
    unsigned char* ACT; const float* bgu;
    __device__ __forceinline__ void operator()(const f32x4 (&acc)[2][2][4][2], const Unit& u, int wr, int wc, int fr, int fq, const LAS unsigned char* meta) const {
        const int f0 = u.pn * HALF + wc * 32 + 8 * fq;
        const float* bp = bgu + (size_t)u.e * (2 * DFF) + f0;
        const f32x4 bg0 = *(const f32x4*)(bp), bg1 = *(const f32x4*)(bp + 4), bu0 = *(const f32x4*)(bp + DFF), bu1 = *(const f32x4*)(bp + DFF + 4);
#pragma unroll
        for (int ai = 0; ai < 2; ++ai)
#pragma unroll
            for (int m = 0; m < 4; ++m) {
                const int lr = ai * HALF + wr * 64 + m * 16 + fr;
                const float rs = __uint_as_float(*(const LAS unsigned*)(meta + lr * 8 + 4)) * 0.015625f;
                const f32x4 g0 = acc[ai][0][m][0] * rs + bg0, g1 = acc[ai][0][m][1] * rs + bg1, p0 = acc[ai][1][m][0] * rs + bu0, p1 = acc[ai][1][m][1] * rs + bu1;
                f32x2 a[4];
#pragma unroll
                for (int h2 = 0; h2 < 4; ++h2) {
                    const f32x4 gs = h2 < 2 ? g0 : g1, us = h2 < 2 ? p0 : p1;
                    f32x2 g, u2; g.x = fminf(gs[2 * (h2 & 1)], 7.0f); g.y = fminf(gs[2 * (h2 & 1) + 1], 7.0f);
                    u2.x = __builtin_amdgcn_fmed3f(us[2 * (h2 & 1)], -7.0f, 7.0f); u2.y = __builtin_amdgcn_fmed3f(us[2 * (h2 & 1) + 1], -7.0f, 7.0f);
                    const f32x2 t = g * (-2.4554669595f);
                    f32x2 e; e.x = __builtin_amdgcn_exp2f(t.x); e.y = __builtin_amdgcn_exp2f(t.y);
                    const f32x2 d = e + 1.0f;
                    f32x2 r; r.x = __builtin_amdgcn_rcpf(d.x); r.y = __builtin_amdgcn_rcpf(d.y);
                    a[h2] = ((u2 * 4.0f + 4.0f) * g) * r;
                }
                u32x2 w8; w8.x = pk4_fp8(a[0].x, a[0].y, a[1].x, a[1].y); w8.y = pk4_fp8(a[2].x, a[2].y, a[3].x, a[3].y);
                *(u32x2*)(ACT + (size_t)(u.pm * 8 + u.pn) * 32768 + lr * 128 + wc * 32 + 8 * fq) = w8;
            }
    }
};
struct EpiDown {
    unsigned char* CONTRIB; const float* bd;
    __device__ __forceinline__ void operator()(const f32x4 (&acc)[2][2][4][2], const Unit& u, int wr, int wc, int fr, int fq, const LAS unsigned char* meta) const {
        const int col0 = u.pn * BM + wc * 64 + 16 * fq;
        const float* bp = bd + (size_t)u.e * DM + col0;
        f32x4 b00 = *(const f32x4*)(bp), b01 = *(const f32x4*)(bp + 4), b10 = *(const f32x4*)(bp + 8), b11 = *(const f32x4*)(bp + 12);
        asm volatile("" : "+v"(b00), "+v"(b01), "+v"(b10), "+v"(b11));
#pragma unroll
        for (int ai = 0; ai < 2; ++ai)
#pragma unroll
            for (int m = 0; m < 4; ++m) {
                const int lr = ai * HALF + wr * 64 + m * 16 + fr;
                const u32x2 rec = *(const LAS u32x2*)(meta + lr * 8);
                const bool valid = lr < u.nvalid;
                const float gt = valid ? __uint_as_float(rec.y) * 16.0f : 0.f;
                const f32x4 y00 = (acc[ai][0][m][0] * 0.00390625f + b00) * gt, y01 = (acc[ai][0][m][1] * 0.00390625f + b01) * gt, y10 = (acc[ai][1][m][0] * 0.00390625f + b10) * gt, y11 = (acc[ai][1][m][1] * 0.00390625f + b11) * gt;
                if (valid) {
                    u32x4 w; w.x = pk4_fp8(y00[0], y00[1], y00[2], y00[3]); w.y = pk4_fp8(y01[0], y01[1], y01[2], y01[3]); w.z = pk4_fp8(y10[0], y10[1], y10[2], y10[3]); w.w = pk4_fp8(y11[0], y11[1], y11[2], y11[3]);
                    *(u32x4*)(CONTRIB + (size_t)rec.x * DM + col0) = w;
                }
            }
    }
};
}

#ifndef PROBE_DUP
#define PROBE_DUP -1
#endif
#define REPS(k) ((PROBE_DUP == (k)) ? 2 : 1)
struct Frame {
    LAS unsigned char* lds; int tid, lane, wave, vcu, G, gw, NGW;
};

template <bool GAIN>
__device__ __forceinline__ void tr_item(const float* W, int N, int k0, int n0, const float* gain, bf16_t* wt_row0, LAS float* scr, int lane) {
    const int kr = lane >> 3, nq = lane & 7;
    f32x4 v[8]; float gk[8];
#pragma unroll
    for (int it = 0; it < 8; ++it) { const int k = k0 + 8 * it + kr; v[it] = *(const f32x4*)(W + (size_t)k * N + n0 + 4 * nq); gk[it] = GAIN ? gain[k] : 1.0f; }
    if (GAIN) {
#pragma unroll
        for (int it = 0; it < 8; ++it) v[it] = v[it] * gk[it];
    }
#pragma unroll
    for (int it = 0; it < 8; ++it) *(LAS f32x4*)(scr + (8 * it + kr) * 32 + ((nq ^ it) << 2)) = v[it];
    LDS_WAIT();
    const int nl = lane >> 3, c = lane & 7;
#pragma unroll
    for (int iter = 0; iter < 4; ++iter) {
        const int n = nl + 8 * iter; const LAS float* s = scr + (8 * c) * 32 + (((n >> 2) ^ c) << 2) + (n & 3);
        u32x4 o; o.x = cvt_pk_bf16(s[0], s[32]); o.y = cvt_pk_bf16(s[64], s[96]); o.z = cvt_pk_bf16(s[128], s[160]); o.w = cvt_pk_bf16(s[192], s[224]);
        *(u32x4*)(wt_row0 + (size_t)n * 1024 + k0 + 8 * c) = o;
    }
    LDS_WAIT();
}

template <bool GAIN>
__device__ __forceinline__ void tr_item_f8(const float* W, int N, int k0, int n0, const float* gain, float scale, unsigned char* wt_row0, LAS float* scr, int lane) {
    const int kr = lane >> 3, nq = lane & 7;
    f32x4 v[8]; float gk[8];
#pragma unroll
    for (int it = 0; it < 8; ++it) { const int k = k0 + 8 * it + kr; v[it] = *(const f32x4*)(W + (size_t)k * N + n0 + 4 * nq); gk[it] = GAIN ? gain[k] * scale : scale; }
#pragma unroll
    for (int it = 0; it < 8; ++it) v[it] = v[it] * gk[it];
#pragma unroll
    for (int it = 0; it < 8; ++it) *(LAS f32x4*)(scr + (8 * it + kr) * 32 + ((nq ^ it) << 2)) = v[it];
    LDS_WAIT();
    const int nl = lane >> 2, c = lane & 3;
#pragma unroll
    for (int iter = 0; iter < 2; ++iter) {
        const int n = nl + 16 * iter; float f[16];
#pragma unroll
        for (int j = 0; j < 16; ++j) { const int k = 16 * c + j; f[j] = scr[k * 32 + (((n >> 2) ^ ((k >> 3) & 7)) << 2) + (n & 3)]; }
        u32x4 o; o.x = pk4_fp8(f[0], f[1], f[2], f[3]); o.y = pk4_fp8(f[4], f[5], f[6], f[7]); o.z = pk4_fp8(f[8], f[9], f[10], f[11]); o.w = pk4_fp8(f[12], f[13], f[14], f[15]);
        *(u32x4*)(wt_row0 + (size_t)n * 1024 + k0 + 16 * c) = o;
    }
    LDS_WAIT();
}

template <bool GAIN>
__device__ __forceinline__ void tr_item_f8w(const float* W, int N, int k0, int n0, const float* gain, float scale, unsigned char* wt_row0, LAS float* scr, int lane) {
    const int kr = lane >> 3, nq = lane & 7;
    f32x4 v[16]; float gk[16];
#pragma unroll
    for (int it = 0; it < 16; ++it) { const int k = k0 + 8 * it + kr; v[it] = *(const f32x4*)(W + (size_t)k * N + n0 + 4 * nq); gk[it] = GAIN ? gain[k] * scale : scale; }
#pragma unroll
    for (int it = 0; it < 16; ++it) *(LAS f32x4*)(scr + (8 * it + kr) * 32 + ((nq ^ (it & 7)) << 2)) = v[it] * gk[it];
    LDS_WAIT();
    const int nl = lane >> 3, c = lane & 7;
#pragma unroll
    for (int iter = 0; iter < 4; ++iter) {
        const int n = nl + 8 * iter; float f[16];
#pragma unroll
        for (int j = 0; j < 16; ++j) { const int k = 16 * c + j; f[j] = scr[k * 32 + (((n >> 2) ^ ((k >> 3) & 7)) << 2) + (n & 3)]; }
        u32x4 o; o.x = pk4_fp8(f[0], f[1], f[2], f[3]); o.y = pk4_fp8(f[4], f[5], f[6], f[7]); o.z = pk4_fp8(f[8], f[9], f[10], f[11]); o.w = pk4_fp8(f[12], f[13], f[14], f[15]);
        *(u32x4*)(wt_row0 + (size_t)n * 1024 + k0 + 16 * c) = o;
    }
    LDS_WAIT();
}

__device__ __forceinline__ s16x4 tr_read_asm(const LAS unsigned char* p) { s16x4 r; asm volatile("ds_read_b64_tr_b16 %0, %1" : "=v"(r) : "v"((unsigned)(uintptr_t)p) : "memory"); return r; }
struct AttCtx { const bf16_t* Q; const bf16_t* KB; const bf16_t* VB; bf16_t* BPART; float* LSE; };
__device__ __forceinline__ void att_decode(int idx, int& n, int& b, int& head, int& dil, int& r, int& q0, int& qb) {
    n = idx >> 11; const int rem = idx & 2047; b = rem >> 7; head = (rem >> 4) & 7; const int j = (rem + (idx >> 8)) & 15, sh = 2 * n;
    dil = 1 << sh; r = j & (dil - 1); qb = j >> sh; q0 = qb * 128;
}
template <int BUFI>
__device__ __forceinline__ void att_issue(LAS unsigned char* lds, const AttCtx& C, int idx, int wave, int lane) {
    int n, b, head, dil, r, q0, qb; att_decode(idx, n, b, head, dil, r, q0, qb);
#pragma unroll
    for (int t = 0; t < 4; ++t) { const int row = 32 * wave + 8 * t + (lane >> 3); int l = q0 - 128 + row; l = l < 0 ? 0 : l;
        const size_t off = kv_off(b, head, l * dil + r) + (((lane & 7) ^ (row & 7)) << 3);
        __builtin_amdgcn_global_load_lds((const unsigned*)(C.KB + off), (LAS unsigned*)(lds + BUFI * 65536 + (32 * wave + 8 * t) * 128), 16, 0, 0);
        __builtin_amdgcn_global_load_lds((const unsigned*)(C.VB + off), (LAS unsigned*)(lds + BUFI * 65536 + 32768 + (32 * wave + 8 * t) * 128), 16, 0, 0); }
}
struct AttNext { unsigned off[4]; int on; };
__device__ __forceinline__ AttNext att_prep(int idx, bool on, int wave, int lane) {
    AttNext x; x.on = on ? 1 : 0;
    int n, b, head, dil, r, q0, qb; att_decode(on ? idx : 0, n, b, head, dil, r, q0, qb);
#pragma unroll
    for (int t = 0; t < 4; ++t) { const int row = 32 * wave + 8 * t + (lane >> 3); int l = q0 - 128 + row; l = l < 0 ? 0 : l;
        x.off[t] = (unsigned)(kv_off(b, head, l * dil + r) + (((lane & 7) ^ (row & 7)) << 3)); }
    return x;
}
template <int BUFI>
__device__ __forceinline__ void att_dma(LAS unsigned char* lds, const AttCtx& C, const AttNext& x, int t, int wave) {
    if (x.on) {
        __builtin_amdgcn_global_load_lds((const unsigned*)(C.KB + x.off[t]), (LAS unsigned*)(lds + BUFI * 65536 + (32 * wave + 8 * t) * 128), 16, 0, 0);
        __builtin_amdgcn_global_load_lds((const unsigned*)(C.VB + x.off[t]), (LAS unsigned*)(lds + BUFI * 65536 + 32768 + (32 * wave + 8 * t) * 128), 16, 0, 0);
    }
}
__device__ __forceinline__ void att_load_q(const AttCtx& C, int unit, int wave, int lane, bf16x8 (&qf)[2]) {
    int n, b, head, dil, r, q0, qb; att_decode(unit, n, b, head, dil, r, q0, qb);
    const int tq = (q0 + 16 * wave + (lane & 15)) * dil + r;
#pragma unroll
    for (int s2 = 0; s2 < 2; ++s2) qf[s2] = *(const bf16x8*)(C.Q + kv_off(b, head, tq) + 32 * s2 + 8 * (lane >> 4));
}
__device__ __forceinline__ float xrow_max(float x) {
    const auto r16 = __builtin_amdgcn_permlane16_swap(__float_as_uint(x), __float_as_uint(x), false, false); x = fmaxf(__uint_as_float(r16[0]), __uint_as_float(r16[1]));
    const auto r32 = __builtin_amdgcn_permlane32_swap(__float_as_uint(x), __float_as_uint(x), false, false); return fmaxf(__uint_as_float(r32[0]), __uint_as_float(r32[1]));
}
__device__ __forceinline__ float xrow_sum(float x) {
    const auto r16 = __builtin_amdgcn_permlane16_swap(__float_as_uint(x), __float_as_uint(x), false, false); x = __uint_as_float(r16[0]) + __uint_as_float(r16[1]);
    const auto r32 = __builtin_amdgcn_permlane32_swap(__float_as_uint(x), __float_as_uint(x), false, false); return __uint_as_float(r32[0]) + __uint_as_float(r32[1]);
}
template <int OFF>
__device__ __forceinline__ s16x4 tr_read_off(unsigned addr) { s16x4 r; asm volatile("ds_read_b64_tr_b16 %0, %1 offset:%2" : "=v"(r) : "v"(addr), "n"(OFF) : "memory"); return r; }
template <int BUFI>
__device__ __forceinline__ float att_unit(LAS unsigned char* lds, const AttCtx& C, int unit, int wave, int lane, const bf16x8 (&qf)[2], const AttNext& nx) {
    const int qi = lane & 15, g = lane >> 4, li = lane & 15;
    int n, b, head, dil, r, q0, qb; att_decode(unit, n, b, head, dil, r, q0, qb);
    const LAS unsigned char* kl = lds + BUFI * 65536; const LAS unsigned char* vl = kl + 32768;
    const int kt0 = (qb == 0) ? (8 - wave) : 0;
    att_dma<BUFI ^ 1>(lds, C, nx, 0, wave);
    f32x4 S[9];
    const LAS unsigned char* kbase = kl + (16 * wave + qi) * 128;
#pragma unroll
    for (int kt = 0; kt < 9; ++kt) {
        f32x4 a = {0.f, 0.f, 0.f, 0.f};
#pragma unroll
        for (int s2 = 0; s2 < 2; ++s2) {
            const bf16x8 kf = *(const LAS bf16x8*)(kbase + kt * 2048 + (((4 * s2 + g) ^ (qi & 7)) << 4));
            a = __builtin_amdgcn_mfma_f32_16x16x32_bf16(kf, qf[s2], a, 0, 0, 0);
        }
#pragma unroll
        for (int v = 0; v < 4; ++v) { const int c = 4 * g + v; bool ok = true; if (kt == 0) ok = c >= qi; if (kt == 8) ok = c <= qi; S[kt][v] = ok ? a[v] : -1e30f; }
    }
    att_dma<BUFI ^ 1>(lds, C, nx, 1, wave);
    float mx = -1e30f;
#pragma unroll
    for (int kt = 0; kt < 9; ++kt) { const float tm = fmaxf(fmaxf(S[kt][0], S[kt][1]), fmaxf(S[kt][2], S[kt][3])); mx = fmaxf(mx, kt >= kt0 ? tm : -1e30f); }
    mx = xrow_max(mx);
    float lsum = 0.f;
#pragma unroll
    for (int kt = 0; kt < 9; ++kt) { const float mk = kt >= kt0 ? mx : 3.0e38f;
#pragma unroll
        for (int v = 0; v < 4; ++v) { const float pv = __builtin_amdgcn_exp2f(S[kt][v] - mk); S[kt][v] = pv; lsum += pv; } }
    lsum = xrow_sum(lsum);
    att_dma<BUFI ^ 1>(lds, C, nx, 2, wave);
    f32x4 o[4];
#pragma unroll
    for (int dt = 0; dt < 4; ++dt) o[dt] = (f32x4){0.f, 0.f, 0.f, 0.f};
    unsigned vb[4];
    { const int row0 = 16 * wave + 4 * g + (li >> 2), pp = li & 3;
#pragma unroll
      for (int dt = 0; dt < 4; ++dt) vb[dt] = (unsigned)(uintptr_t)(vl + row0 * 128 + (((2 * dt + (pp >> 1)) ^ (row0 & 7)) << 4) + 8 * (pp & 1)); }
    s16x4 lo[2][4], hi[2][4];
#define ATT_TR(set, KA, KB) do { _Pragma("unroll") for (int dt = 0; dt < 4; ++dt) { lo[set][dt] = tr_read_off<(KA) * 2048>(vb[dt]); hi[set][dt] = tr_read_off<(KB) * 2048>(vb[dt]); } } while (0)
#define ATT_PV(set, KA, KB, PAIRED, WAITN) do { \
        u32x4 pw; pw.x = cvt_pk_bf16(S[KA][0], S[KA][1]); pw.y = cvt_pk_bf16(S[KA][2], S[KA][3]); \
        if (PAIRED) { pw.z = cvt_pk_bf16(S[KB][0], S[KB][1]); pw.w = cvt_pk_bf16(S[KB][2], S[KB][3]); } else { pw.z = 0u; pw.w = 0u; } \
        const bf16x8 pb = __builtin_bit_cast(bf16x8, pw); \
        asm volatile("s_waitcnt lgkmcnt(" #WAITN ")" : "+v"(lo[set][0]), "+v"(lo[set][1]), "+v"(lo[set][2]), "+v"(lo[set][3]), "+v"(hi[set][0]), "+v"(hi[set][1]), "+v"(hi[set][2]), "+v"(hi[set][3]) :: "memory"); __builtin_amdgcn_sched_barrier(0); \
        _Pragma("unroll") for (int dt = 0; dt < 4; ++dt) { \
            const bf16x8 va = (bf16x8){lo[set][dt][0], lo[set][dt][1], lo[set][dt][2], lo[set][dt][3], hi[set][dt][0], hi[set][dt][1], hi[set][dt][2], hi[set][dt][3]}; \
            o[dt] = __builtin_amdgcn_mfma_f32_16x16x32_bf16(va, pb, o[dt], 0, 0, 0); } } while (0)
    ATT_TR(0, 0, 1);
    ATT_TR(1, 2, 3); ATT_PV(0, 0, 1, true, 8);
    ATT_TR(0, 4, 5); ATT_PV(1, 2, 3, true, 8);
    att_dma<BUFI ^ 1>(lds, C, nx, 3, wave);
    ATT_TR(1, 6, 7); ATT_PV(0, 4, 5, true, 8);
    ATT_TR(0, 8, 8); ATT_PV(1, 6, 7, true, 8);
    ATT_PV(0, 8, 8, false, 0);
#undef ATT_TR
#undef ATT_PV
    const float inv = 1.0f / lsum;
    LAS unsigned char* ost = lds + (OST_OFF - RING_OFF) + wave * 2048;
#pragma unroll
    for (int dt = 0; dt < 4; ++dt) { u32x2 w; w.x = cvt_pk_bf16(o[dt][0] * inv, o[dt][1] * inv); w.y = cvt_pk_bf16(o[dt][2] * inv, o[dt][3] * inv); *(LAS u32x2*)(ost + qi * 128 + 32 * dt + 8 * g) = w; }
    return mx + __builtin_amdgcn_logf(lsum);
}
__device__ __forceinline__ void att_store(LAS unsigned char* lds, const AttCtx& C, int unit, int wave, int lane, float lse) {
    int n, b, head, dil, r, q0, qb; att_decode(unit, n, b, head, dil, r, q0, qb);
    const LAS unsigned char* ost = lds + (OST_OFF - RING_OFF) + wave * 2048;
    LDS_WAIT();
#pragma unroll
    for (int jr = 0; jr < 2; ++jr) {
        const int row = 8 * jr + (lane >> 3), tr = (q0 + 16 * wave + row) * dil + r;
        const u32x4 ov = *(const LAS u32x4*)(ost + row * 128 + (lane & 7) * 16);
        *(u32x4*)(C.BPART + (size_t)n * T * AW + kv_off(b, head, tr) + (lane & 7) * 8) = ov;
    }
    const int tq = (q0 + 16 * wave + (lane & 15)) * dil + r;
    if ((lane >> 4) == 0) C.LSE[(size_t)n * T * NH + kv_off(b, head, tq) / HD] = lse;
    LDS_WAIT();
}

struct Args { const float* in[18]; float* out; unsigned char* ws; };
typedef const __attribute__((address_space(4))) Args* KArgs;
__device__ __forceinline__ KArgs kargs() { KArgs p = (KArgs)__builtin_amdgcn_kernarg_segment_ptr(); asm volatile("" : "+s"(p)); return p; }
#define KIN(k) (ka->in[k])
#define KWS(Tp, off) ((Tp*)(ka->ws + (off)))
constexpr int CV_I_IN = 16 * (INW / 32), CV_I_OUT = 16 * (DM / 32), CV_I_GU = NE * 8 * (2 * DFF / 32), CV_I_D = NE * 8 * (DM / 32), CV_NITEMS = CV_I_IN + CV_I_OUT + CV_I_GU + CV_I_D;
__device__ __forceinline__ void convert_items(LAS float* scr, int lane, int gw, int NGW, int it_begin, int it_end) {
    const KArgs ka = kargs();
    const float* const norm1_g = KIN(1); const float* const w_in = KIN(2); const float* const a_out_g = KIN(7); const float* const b_out_g = KIN(8); const float* const w_out = KIN(9); const float* const norm2_g = KIN(10);
    const float* const w_gate_up = KIN(13); const float* const w_down = KIN(15);
    bf16_t* const WIN = KWS(bf16_t, WS_WIN); bf16_t* const WOUT = KWS(bf16_t, WS_WOUT); unsigned char* const WGU = KWS(unsigned char, WS_WGU); unsigned char* const WD = KWS(unsigned char, WS_WD);
    constexpr int I_IN = CV_I_IN, I_OUT = CV_I_OUT, I_GU = CV_I_GU;
        for (int it = it_begin + gw; it < it_end; it += NGW) {
        int r = it;
        if (r < I_IN) { const int nb = r % (INW / 32), kb = r / (INW / 32), n0 = nb * 32, tile = n0 >> 8, within = n0 & 255, wcc = within >> 6, bj = (within >> 5) & 1;
            tr_item<true>(w_in, INW, kb * 64, n0, norm1_g, WIN + (size_t)(tile * 256 + 128 * bj + 32 * wcc) * 1024, scr, lane); continue; }
        r -= I_IN;
        if (r < I_OUT) { const int nb = r % (DM / 32), kb = r / (DM / 32), n0 = nb * 32, k0 = kb * 64;
            tr_item<true>(w_out, DM, k0, n0, k0 < AW ? a_out_g : b_out_g - AW, WOUT + (size_t)n0 * 1024, scr, lane); continue; }
        r -= I_OUT;
        if (r < I_GU) { const int e = r / (8 * 64), rr = r % (8 * 64), nb = rr % 64, kb = rr / 64, n0 = nb * 32, bj = n0 >> 10, f = n0 & 1023, pn = f >> 7, wcc = (f >> 5) & 3;
            tr_item_f8w<true>(w_gate_up + (size_t)e * 1024 * 2048, 2 * DFF, kb * 128, n0, norm2_g, 64.0f, WGU + ((size_t)e * 2048 + pn * 256 + 128 * bj + 32 * wcc) * 1024, scr, lane); continue; }
        r -= I_GU;
        { const int e = r / (8 * 32), rr = r % (8 * 32), nb = rr % 32, kb = rr / 32, n0 = nb * 32;
            tr_item_f8w<false>(w_down + (size_t)e * 1024 * 1024, DM, kb * 128, n0, nullptr, 64.0f, WD + ((size_t)e * 1024 + n0) * 1024, scr, lane); }
    }
}

struct CvX { const float* src; unsigned char* dst; int N, gb, gu; };
constexpr int CVW_GU = NE * 8 * 8, CVW_D = NE * 8 * 4, CVW_N = CVW_GU + CVW_D;
__device__ __forceinline__ CvX cvx_decode(int r, int wave, const float* w_gate_up, const float* w_down, unsigned char* WGU, unsigned char* WD) {
    CvX d;
    if (r < CVW_GU) { const int e = r >> 6, kb = (r >> 3) & 7, nb = r & 7, k0 = kb * 128 + 16 * wave;
        d.src = w_gate_up + (size_t)e * 1024 * 2048 + (size_t)k0 * 2048 + nb * 256; d.N = 2 * DFF; d.gb = k0; d.gu = 1;
        const int bj = nb >> 2, pn0 = (nb & 3) * 2;
        d.dst = WGU + (size_t)(e * 8 + pn0) * 262144 + kb * 32768 + (128 * bj) * 128; }
    else { const int q = r - CVW_GU, e = q >> 5, kb = (q >> 2) & 7, nb = q & 3, k0 = kb * 128 + 16 * wave;
        d.src = w_down + (size_t)e * 1024 * 1024 + (size_t)k0 * 1024 + nb * 256; d.N = DM; d.gb = 1024; d.gu = 0;
        d.dst = WD + (size_t)(e * 4 + nb) * 262144 + kb * 32768; }
    return d;
}
__device__ __forceinline__ void cvx_load(const CvX& d, int lane, f32x4 (&v)[16]) {
#pragma unroll
    for (int kk = 0; kk < 16; ++kk) v[kk] = __builtin_nontemporal_load((const f32x4*)(d.src + (size_t)kk * d.N + 4 * lane));
}
__device__ __forceinline__ void cvx_process(const CvX& d, const f32x4 (&v)[16], const LAS float* gtab, LAS unsigned char* img, int lane, int wave) {
    float g[16];
#pragma unroll
    for (int kk = 0; kk < 16; ++kk) g[kk] = gtab[d.gb + kk];
#pragma unroll
    for (int i = 0; i < 4; ++i) {
        u32x4 o; const int c = 4 * lane + i;
        o.x = pk4_fp8(v[0][i] * g[0], v[1][i] * g[1], v[2][i] * g[2], v[3][i] * g[3]); o.y = pk4_fp8(v[4][i] * g[4], v[5][i] * g[5], v[6][i] * g[6], v[7][i] * g[7]);
        o.z = pk4_fp8(v[8][i] * g[8], v[9][i] * g[9], v[10][i] * g[10], v[11][i] * g[11]); o.w = pk4_fp8(v[12][i] * g[12], v[13][i] * g[13], v[14][i] * g[14], v[15][i] * g[15]);
        *(LAS u32x4*)(img + c * 128 + ((wave ^ (c & 7)) << 4)) = o;
    }
    LDS_WAIT(); __builtin_amdgcn_s_barrier(); asm volatile("" ::: "memory");
#pragma unroll
    for (int t = 0; t < 4; ++t) {
        const int c = 32 * wave + 8 * t + (lane >> 3), j = lane & 7, rowb = d.gu ? ((c >> 7) * 262144 + (c & 127) * 128) : c * 128;
        const u32x4 o = *(const LAS u32x4*)(img + c * 128 + ((j ^ (c & 7)) << 4));
        *(u32x4*)(d.dst + rowb + 16 * j) = o;
    }
}
__device__ __forceinline__ void convert_experts(const LAS float* gtab, LAS unsigned char* img, int lane, int wave, int vcu, int G) {
    const KArgs ka = kargs();
    const float* const w_gate_up = KIN(13); const float* const w_down = KIN(15); unsigned char* const WGU = KWS(unsigned char, WS_WGU); unsigned char* const WD = KWS(unsigned char, WS_WD);
    constexpr int NI = CVW_N;
    f32x4 va[16], vb[16];
    int it = vcu; if (it >= NI) return;
    CvX da = cvx_decode(it, wave, w_gate_up, w_down, WGU, WD), db; cvx_load(da, lane, va);
    for (;;) {
        int nx = it + G;
        db = cvx_decode(nx < NI ? nx : it, wave, w_gate_up, w_down, WGU, WD); cvx_load(db, lane, vb);
        cvx_process(da, va, gtab, img, lane, wave);
        if (nx >= NI) break;
        it = nx; nx = it + G;
        da = cvx_decode(nx < NI ? nx : it, wave, w_gate_up, w_down, WGU, WD); cvx_load(da, lane, va);
        cvx_process(db, vb, gtab, img + 32768, lane, wave);
        if (nx >= NI) break;
        it = nx;
    }
}

__global__ void __launch_bounds__(512, 2) fwd_kernel(Args args) {
    extern __shared__ __attribute__((aligned(16))) unsigned char lds_raw[];
    Frame F;
    F.lds = (LAS unsigned char*)lds_raw;
    F.tid = 0; F.lane = 0; F.wave = __builtin_amdgcn_readfirstlane((int)threadIdx.x >> 6);
    F.G = gridDim.x; { const int bx = blockIdx.x; F.vcu = (F.G % 8 == 0) ? (bx % 8) * (F.G / 8) + bx / 8 : bx; }
    F.gw = F.vcu * 8 + F.wave; F.NGW = F.G * 8;
    const int wave = F.wave;
    gu32* const ctl = (gu32*)(kargs()->ws + WS_CTL);

    for (int u = threadIdx.x; u < (LDS_BYTES - LDSCTL_OFF) / 4; u += 512) ((LAS unsigned*)(F.lds + LDSCTL_OFF))[u] = 0u;
    __syncthreads();
    XcdBarrier bar = xcd_barrier_post((unsigned*)(ctl + CW_BAR), (volatile LAS unsigned*)(F.lds + MISC_OFF) + 8);

    for (int rep = 0; rep < REPS(0); ++rep) {
        const int tid = fresh_tid(), lane = tid & 63;
        const KArgs ka = kargs();
        const float* const x = KIN(0); const float* const norm1_g = KIN(1); const float* const w_in = KIN(2); const float* const a_w_s = KIN(5);
        const float* const a_out_g = KIN(7); const float* const b_out_g = KIN(8); const float* const w_out = KIN(9); const float* const norm2_g = KIN(10); const float* const w_router = KIN(11);
        const float* const w_gate_up = KIN(13); const float* const w_down = KIN(15);
        bf16_t* const WRH = KWS(bf16_t, WS_WRT); bf16_t* const WRL = KWS(bf16_t, WS_WRT + 64 * KiB); bf16_t* const WSB = KWS(bf16_t, WS_WSB); float* const COS = KWS(float, WS_COS); float* const SIN = KWS(float, WS_SIN); float* const R1 = KWS(float, WS_R1);
        bf16_t* const WIN = KWS(bf16_t, WS_WIN); bf16_t* const WOUT = KWS(bf16_t, WS_WOUT); unsigned char* const WGU = KWS(unsigned char, WS_WGU); unsigned char* const WD = KWS(unsigned char, WS_WD); bf16_t* const XB = KWS(bf16_t, WS_XB);
        LAS float* scr = (LAS float*)(F.lds + RING_OFF + wave * 16384);
        convert_items(scr, lane, F.gw, F.NGW, 0, CV_I_IN + CV_I_OUT);
        for (int m0 = F.gw; m0 < T; m0 += 4 * F.NGW) {
            f32x4 v[4][4];
#pragma unroll
            for (int q = 0; q < 4; ++q) { const f32x4* xr = (const f32x4*)(x + (size_t)(m0 + q * F.NGW) * DM) + lane;
#pragma unroll
                for (int j = 0; j < 4; ++j) v[q][j] = __builtin_nontemporal_load(xr + 64 * j); }
#pragma unroll
            for (int q = 0; q < 4; ++q) {
                const int m = m0 + q * F.NGW; float sq = 0.f;
#pragma unroll
                for (int j = 0; j < 4; ++j) sq += (v[q][j].x * v[q][j].x + v[q][j].y * v[q][j].y) + (v[q][j].z * v[q][j].z + v[q][j].w * v[q][j].w);
                sq = wave_sum(sq);
                u32x2* o8 = (u32x2*)(XB + (size_t)m * DM) + lane;
#pragma unroll
                for (int j = 0; j < 4; ++j) { u32x2 w; w.x = cvt_pk_bf16(v[q][j].x, v[q][j].y); w.y = cvt_pk_bf16(v[q][j].z, v[q][j].w); o8[64 * j] = w; }
                if (lane == 0) R1[m] = 1.0f / sqrtf(sq * (1.0f / DM) + NORM_EPS);
            }
        }
        const int gt = F.vcu * 512 + tid, NGT = F.G * 512;
        for (int i = gt; i < SEQ * 32; i += NGT) {
            const int pos = i >> 5, d = i & 31;
            const float inv = (float)exp2(-(double)(2 * d) * (13.287712379549449 / 64.0));
            const float ang = (float)pos * inv;
            const double a = (double)ang; const double kq = rint(a * 0.15915494309189535); const float rr = (float)(a - kq * 6.283185307179586);
            COS[i] = cosf(rr); SIN[i] = sinf(rr);
        }
        for (int i = gt; i < NH * CHUNK * CHUNK; i += NGT) { const int s = i & 127, t = (i >> 7) & 127; const float w = (s <= t) ? a_w_s[i] : 0.f; WSB[i] = (bf16_t)(cvt_pk_bf16(w, 0.f) & 0xffffu); }
        for (int i = gt; i < NE * DM; i += NGT) {
            const int e = i >> 10, k = i & 1023; const float w = w_router[k * NE + e] * norm2_g[k];
            const unsigned hi = cvt_pk_bf16(w, 0.f) & 0xffffu; const float lo = w - __uint_as_float(hi << 16);
            WRH[i] = (bf16_t)hi; WRL[i] = (bf16_t)(cvt_pk_bf16(lo, 0.f) & 0xffffu); }
    }
    xcd_barrier(bar);

    for (int rep = 0; rep < REPS(1); ++rep) {
        const KArgs ka = kargs();
        pg8::DenseSched S{KWS(const char, WS_XB), KWS(const char, WS_WIN), T / 256, INW / 256, F.G, (int)blockIdx.x};
        pg8::EpiProj E{KWS(bf16_t, WS_U), KWS(bf16_t, WS_VN), KWS(bf16_t, WS_Q), KWS(bf16_t, WS_K), KWS(bf16_t, WS_V), KWS(float, WS_R1), KWS(float, WS_COS), KWS(float, WS_SIN), KIN(3), KIN(4)};
        pg8::gemm_phase<pg8::EpiProj, pg8::DenseSched>(F.lds + RING_OFF, S, E);
    }
    xcd_barrier(bar);

    for (int rep = 0; rep < REPS(2); ++rep)
    for (int unit = F.vcu; unit < BATCH * (SEQ / CHUNK); unit += F.G) {
        const int tid = fresh_tid(), lane = tid & 63; (void)tid;
        const KArgs ka = kargs();
        const float* const a_b_s = KIN(6); const bf16_t* const VN = KWS(bf16_t, WS_VN); const bf16_t* const U = KWS(bf16_t, WS_U); const bf16_t* const WSB = KWS(bf16_t, WS_WSB); bf16_t* const MIXED = KWS(bf16_t, WS_MIXED);
        const int tok0 = unit * CHUNK, h = wave, hh = lane >> 5, g16 = lane >> 4, li = lane & 15;
        LAS unsigned char* vl = F.lds + RING_OFF + wave * 16384;
        {
            const int cc = lane & 7, rb = lane >> 3;
            u32x4 tmp[16];
#pragma unroll
            for (int it = 0; it < 16; ++it) { const int row = rb + 8 * it; tmp[it] = *(const u32x4*)(VN + (size_t)(tok0 + row) * AW + h * HD + cc * 8); }
#pragma unroll
            for (int it = 0; it < 16; ++it) { const int row = rb + 8 * it; *(LAS u32x4*)(vl + row * 128 + ((cc ^ (row & 7)) << 4)) = tmp[it]; }
            LDS_WAIT();
        }
        bf16x8 wsf[10][2];
#pragma unroll
        for (int tb = 0; tb < 4; ++tb)
#pragma unroll
            for (int st = 0; st <= tb; ++st)
#pragma unroll
                for (int s2 = 0; s2 < 2; ++s2) wsf[tb * (tb + 1) / 2 + st][s2] = *(const bf16x8*)(WSB + ((size_t)h * CHUNK + 32 * tb + (lane & 31)) * CHUNK + 32 * st + 16 * s2 + 8 * hh);
        f32x16 araw[4][2];
#pragma unroll
        for (int tb = 0; tb < 4; ++tb) {
            f32x16 g0, g1;
#pragma unroll
            for (int v = 0; v < 16; ++v) { g0[v] = 0.f; g1[v] = 0.f; }
            const int t = 32 * tb + (lane & 31);
#pragma unroll
            for (int st = 0; st <= tb; ++st)
#pragma unroll
                for (int s2 = 0; s2 < 2; ++s2) {
                    const int s0 = 32 * st + 16 * s2;
                    const bf16x8 wb = wsf[tb * (tb + 1) / 2 + st][s2];
                    const int rowa = s0 + 8 * hh + (li >> 2), rowb = rowa + 4, pp = li & 3;
#pragma unroll
                    for (int dt = 0; dt < 2; ++dt) {
                        const int chunk = 4 * dt + 2 * (g16 & 1) + (pp >> 1);
                        const s16x4 lo = __builtin_bit_cast(s16x4, __builtin_amdgcn_ds_read_tr16_b64_v4i16((LAS s16x4*)(vl + rowa * 128 + ((chunk ^ (rowa & 7)) << 4) + 8 * (pp & 1))));
                        const s16x4 hi = __builtin_bit_cast(s16x4, __builtin_amdgcn_ds_read_tr16_b64_v4i16((LAS s16x4*)(vl + rowb * 128 + ((chunk ^ (rowb & 7)) << 4) + 8 * (pp & 1))));
                        const bf16x8 va = (bf16x8){lo[0], lo[1], lo[2], lo[3], hi[0], hi[1], hi[2], hi[3]};
                        if (dt == 0) g0 = __builtin_amdgcn_mfma_f32_32x32x16_bf16(va, wb, g0, 0, 0, 0); else g1 = __builtin_amdgcn_mfma_f32_32x32x16_bf16(va, wb, g1, 0, 0, 0);
                    }
                }
            araw[tb][0] = g0; araw[tb][1] = g1;
        }
        {
            LDS_WAIT();
            const int cc = lane & 7, rb = lane >> 3;
            u32x4 tmp[16];
#pragma unroll
            for (int it = 0; it < 16; ++it) { const int row = rb + 8 * it; tmp[it] = *(const u32x4*)(U + (size_t)(tok0 + row) * AW + h * HD + cc * 8); }
#pragma unroll
            for (int it = 0; it < 16; ++it) { const int row = rb + 8 * it; *(LAS u32x4*)(vl + row * 128 + ((cc ^ (row & 7)) << 4)) = tmp[it]; }
            LDS_WAIT();
        }
#pragma unroll
        for (int tb = 0; tb < 4; ++tb) {
            const int t = 32 * tb + (lane & 31);
            const float bias = a_b_s[h * CHUNK + t];
            float sq = 0.f;
#pragma unroll
            for (int g = 0; g < 4; ++g) {
                const u32x2 u0 = *(const LAS u32x2*)(vl + t * 128 + ((g ^ (t & 7)) << 4) + 8 * hh), u1 = *(const LAS u32x2*)(vl + t * 128 + (((4 + g) ^ (t & 7)) << 4) + 8 * hh);
                const float a0 = bf_lo(u0.x) * (araw[tb][0][4 * g] + bias), a1 = bf_hi(u0.x) * (araw[tb][0][4 * g + 1] + bias), a2 = bf_lo(u0.y) * (araw[tb][0][4 * g + 2] + bias), a3 = bf_hi(u0.y) * (araw[tb][0][4 * g + 3] + bias);
                const float c0 = bf_lo(u1.x) * (araw[tb][1][4 * g] + bias), c1 = bf_hi(u1.x) * (araw[tb][1][4 * g + 1] + bias), c2 = bf_lo(u1.y) * (araw[tb][1][4 * g + 2] + bias), c3 = bf_hi(u1.y) * (araw[tb][1][4 * g + 3] + bias);
                araw[tb][0][4 * g] = a0; araw[tb][0][4 * g + 1] = a1; araw[tb][0][4 * g + 2] = a2; araw[tb][0][4 * g + 3] = a3;
                araw[tb][1][4 * g] = c0; araw[tb][1][4 * g + 1] = c1; araw[tb][1][4 * g + 2] = c2; araw[tb][1][4 * g + 3] = c3;
                sq += (a0 * a0 + a1 * a1) + (a2 * a2 + a3 * a3) + (c0 * c0 + c1 * c1) + (c2 * c2 + c3 * c3);
            }
            sq += __shfl_xor(sq, 32);
            if (lane < 32) ((LAS float*)(F.lds + EXCH_OFF))[h * CHUNK + t] = sq;
        }
        __syncthreads();
#pragma unroll
        for (int tb = 0; tb < 4; ++tb) {
            const int t = 32 * tb + (lane & 31);
            float tot = 0.f;
#pragma unroll
            for (int k = 0; k < NH; ++k) tot += ((LAS float*)(F.lds + EXCH_OFF))[k * CHUNK + t];
            const float rstd = 1.0f / sqrtf(tot * (1.0f / AW) + NORM_EPS);
#pragma unroll
            for (int g = 0; g < 4; ++g) {
                u32x2 w0, w1;
                w0.x = cvt_pk_bf16(araw[tb][0][4 * g] * rstd, araw[tb][0][4 * g + 1] * rstd); w0.y = cvt_pk_bf16(araw[tb][0][4 * g + 2] * rstd, araw[tb][0][4 * g + 3] * rstd);
                w1.x = cvt_pk_bf16(araw[tb][1][4 * g] * rstd, araw[tb][1][4 * g + 1] * rstd); w1.y = cvt_pk_bf16(araw[tb][1][4 * g + 2] * rstd, araw[tb][1][4 * g + 3] * rstd);
                *(LAS u32x2*)(vl + t * 128 + ((g ^ (t & 7)) << 4) + 8 * hh) = w0; *(LAS u32x2*)(vl + t * 128 + (((4 + g) ^ (t & 7)) << 4) + 8 * hh) = w1;
            }
        }
        {
            LDS_WAIT();
            const int cc = lane & 7, rb = lane >> 3;
#pragma unroll
            for (int it = 0; it < 16; ++it) { const int row = rb + 8 * it; const u32x4 o = *(const LAS u32x4*)(vl + row * 128 + ((cc ^ (row & 7)) << 4)); *(u32x4*)(MIXED + (size_t)(tok0 + row) * DM + h * HD + cc * 8) = o; }
        }
        __syncthreads();
    }

    {
        const int tid = fresh_tid(), lane = tid & 63; (void)tid;
        const KArgs ka = kargs();
        const AttCtx C{KWS(bf16_t, WS_Q), KWS(bf16_t, WS_K), KWS(bf16_t, WS_V), KWS(bf16_t, WS_BPART), KWS(float, WS_LSE)};
        constexpr int NUNIT = 3 * 2048;
        LAS unsigned char* const al = F.lds + RING_OFF;
        bf16x8 qa[2], qb2[2];
        if (F.vcu < NUNIT) { att_issue<0>(al, C, F.vcu, wave, lane); att_load_q(C, F.vcu, wave, lane, qa); }
        __syncthreads();
        float lse = 0.f; int prev = -1;
        for (int unit = F.vcu; unit < NUNIT; unit += 2 * F.G) {
            { const bool on = unit + F.G < NUNIT; const AttNext nx = att_prep(unit + F.G, on, wave, lane);
              if (on) att_load_q(C, unit + F.G, wave, lane, qb2);
              if (prev >= 0) att_store(al, C, prev, wave, lane, lse);
              lse = att_unit<0>(al, C, unit, wave, lane, qa, nx); prev = unit; }
            __syncthreads();
            if (unit + F.G < NUNIT) {
                const bool on = unit + 2 * F.G < NUNIT; const AttNext nx = att_prep(unit + 2 * F.G, on, wave, lane);
                if (on) att_load_q(C, unit + 2 * F.G, wave, lane, qa);
                att_store(al, C, prev, wave, lane, lse);
                lse = att_unit<1>(al, C, unit + F.G, wave, lane, qb2, nx); prev = unit + F.G;
                __syncthreads();
            }
        }
        if (prev >= 0) att_store(al, C, prev, wave, lane, lse);
    }
    xcd_barrier(bar);

    for (int rep = 0; rep < REPS(4); ++rep)
    for (int mo = F.gw; mo < T; mo += F.NGW) {
        const int m = (mo & ~(SEQ - 1)) + ((mo & 127) << 4) + ((mo >> 7) & 15);
        const int lane = fresh_tid() & 63;
        const KArgs ka = kargs();
        const bf16_t* const BPART = KWS(bf16_t, WS_BPART); const float* const LSE = KWS(float, WS_LSE); bf16_t* const MIXED = KWS(bf16_t, WS_MIXED);
        const int head = lane >> 3;
        float L[3]; u32x4 ov[3];
#pragma unroll
        for (int n = 0; n < 3; ++n) { const size_t ro = kv_off(m >> 11, head, m & (SEQ - 1)); L[n] = LSE[(size_t)n * T * NH + ro / HD]; ov[n] = *(const u32x4*)(BPART + (size_t)n * T * AW + ro + (lane & 7) * 8); }
        const float mx = fmaxf(L[0], fmaxf(L[1], L[2]));
        float w[3]; w[0] = __builtin_amdgcn_exp2f(L[0] - mx); w[1] = __builtin_amdgcn_exp2f(L[1] - mx); w[2] = __builtin_amdgcn_exp2f(L[2] - mx);
        const float inv = 1.0f / (w[0] + w[1] + w[2]);
        float o[8];
#pragma unroll
        for (int k = 0; k < 8; ++k) o[k] = 0.f;
#pragma unroll
        for (int n = 0; n < 3; ++n) { const float wn = w[n] * inv;
            o[0] += wn * bf_lo(ov[n].x); o[1] += wn * bf_hi(ov[n].x); o[2] += wn * bf_lo(ov[n].y); o[3] += wn * bf_hi(ov[n].y);
            o[4] += wn * bf_lo(ov[n].z); o[5] += wn * bf_hi(ov[n].z); o[6] += wn * bf_lo(ov[n].w); o[7] += wn * bf_hi(ov[n].w); }
        float s = 0.f;
#pragma unroll
        for (int k = 0; k < 8; ++k) s += o[k] * o[k];
        s = wave_sum(s);
        const float rstd = 1.0f / sqrtf(s * (1.0f / AW) + NORM_EPS);
        u32x4 wv; wv.x = cvt_pk_bf16(o[0] * rstd, o[1] * rstd); wv.y = cvt_pk_bf16(o[2] * rstd, o[3] * rstd); wv.z = cvt_pk_bf16(o[4] * rstd, o[5] * rstd); wv.w = cvt_pk_bf16(o[6] * rstd, o[7] * rstd);
        *(u32x4*)(MIXED + (size_t)m * DM + AW + lane * 8) = wv;
    }
    xcd_barrier(bar);

    for (int rep = 0; rep < REPS(5); ++rep) {
        const KArgs ka = kargs();
        pg8::DenseSched S{KWS(const char, WS_MIXED), KWS(const char, WS_WOUT), T / 256, DM / 256, F.G, (int)blockIdx.x};
        pg8::EpiOut E{KWS(const bf16_t, WS_XB), KWS(bf16_t, WS_HB), KWS(unsigned char, WS_H)};
        pg8::gemm_phase<pg8::EpiOut, pg8::DenseSched>(F.lds + RING_OFF, S, E);
    }
    xcd_barrier(bar);

    { const KArgs ka = kargs(); const float* const norm2_g = KIN(10); LAS float* gt = (LAS float*)(F.lds + GTAB_OFF);
      for (int i = fresh_tid(); i < DM + 128; i += 512) gt[i] = i < DM ? norm2_g[i] * 64.0f : 64.0f;
      __syncthreads(); }
    if (F.vcu & 1) { convert_experts((const LAS float*)(F.lds + GTAB_OFF), F.lds + RING_OFF, fresh_tid() & 63, wave, F.vcu, F.G); __syncthreads(); }
    for (int blk = F.vcu; blk < T / 128; blk += F.G) {
        const int tid = fresh_tid(), lane = tid & 63;
        const KArgs ka = kargs();
        const float* const b_router = KIN(12); const bf16_t* const HB = KWS(bf16_t, WS_HB); const bf16_t* const WRH = KWS(bf16_t, WS_WRT); const bf16_t* const WRL = KWS(bf16_t, WS_WRT + 64 * KiB); float* const R2 = KWS(float, WS_R2);
        u32x2* const LISTR = KWS(u32x2, WS_LISTR); u32x2* const LISTG = KWS(u32x2, WS_LISTG);
        const int t0 = blk * 128 + wave * 16, nn = lane & 15, q4 = lane >> 4, kb = 128 * wave;
        LAS float* part = (LAS float*)(F.lds + RING_OFF) + wave * 4096;
        LAS float* ssqp = (LAS float*)(F.lds + EXCH_OFF) + wave * 128;
        LAS float* lg = (LAS float*)(F.lds + META_OFF + wave * 2816);
        LAS int* selE = (LAS int*)(F.lds + META_OFF + wave * 2816 + 2112);
        LAS float* selG = (LAS float*)(F.lds + META_OFF + wave * 2816 + 2368);
        LAS int* hist = (LAS int*)(F.lds + HIST_OFF); LAS int* basee = hist + 32;
        if (tid < 32) hist[tid] = 0;
        bf16x8 a0[4], a1[4], l0[4], l1[4];
#pragma unroll
        for (int s2 = 0; s2 < 4; ++s2) { const int ko = kb + 32 * s2 + 8 * q4;
            a0[s2] = *(const bf16x8*)(WRH + (size_t)nn * DM + ko); a1[s2] = *(const bf16x8*)(WRH + (size_t)(16 + nn) * DM + ko);
            l0[s2] = *(const bf16x8*)(WRL + (size_t)nn * DM + ko); l1[s2] = *(const bf16x8*)(WRL + (size_t)(16 + nn) * DM + ko); }
#pragma unroll
        for (int half = 0; half < 2; ++half) {
            u32x4 hb[4][4];
#pragma unroll
            for (int g = 0; g < 4; ++g)
#pragma unroll
                for (int s2 = 0; s2 < 4; ++s2) hb[g][s2] = *(const u32x4*)(HB + (size_t)(blk * 128 + 16 * (4 * half + g) + nn) * DM + kb + 32 * s2 + 8 * q4);
#pragma unroll
            for (int g = 0; g < 4; ++g) {
                f32x4 acc0 = {0.f, 0.f, 0.f, 0.f}, acc1 = {0.f, 0.f, 0.f, 0.f}; float ssq = 0.f;
#pragma unroll
                for (int s2 = 0; s2 < 4; ++s2) {
                    const u32x4 hw = hb[g][s2]; const bf16x8 hv = __builtin_bit_cast(bf16x8, hw);
                    const float h0 = bf_lo(hw.x), h1 = bf_hi(hw.x), h2 = bf_lo(hw.y), h3 = bf_hi(hw.y), h4 = bf_lo(hw.z), h5 = bf_hi(hw.z), h6 = bf_lo(hw.w), h7 = bf_hi(hw.w);
                    ssq += ((h0 * h0 + h1 * h1) + (h2 * h2 + h3 * h3)) + ((h4 * h4 + h5 * h5) + (h6 * h6 + h7 * h7));
                    acc0 = __builtin_amdgcn_mfma_f32_16x16x32_bf16(a0[s2], hv, acc0, 0, 0, 0); acc1 = __builtin_amdgcn_mfma_f32_16x16x32_bf16(a1[s2], hv, acc1, 0, 0, 0);
                    acc0 = __builtin_amdgcn_mfma_f32_16x16x32_bf16(l0[s2], hv, acc0, 0, 0, 0); acc1 = __builtin_amdgcn_mfma_f32_16x16x32_bf16(l1[s2], hv, acc1, 0, 0, 0);
                }
                ssq += __shfl_xor(ssq, 16); ssq += __shfl_xor(ssq, 32);
                const int tok = 16 * (4 * half + g) + nn;
                *(LAS f32x4*)(part + tok * 32 + 4 * q4) = acc0; *(LAS f32x4*)(part + tok * 32 + 16 + 4 * q4) = acc1;
                if (q4 == 0) ssqp[tok] = ssq;
            }
        }
        LDS_WAIT();
        __syncthreads();
        const int tl = lane >> 2, pq = lane & 3;
        f32x4 s0 = {0.f, 0.f, 0.f, 0.f}, s1 = {0.f, 0.f, 0.f, 0.f}; float ssq = 0.f;
#pragma unroll
        for (int pw = 0; pw < 8; ++pw) { const LAS float* pp = (const LAS float*)(F.lds + RING_OFF) + pw * 4096 + (16 * wave + tl) * 32 + 8 * pq;
            s0 += *(const LAS f32x4*)pp; s1 += *(const LAS f32x4*)(pp + 4); ssq += ((const LAS float*)(F.lds + EXCH_OFF))[pw * 128 + 16 * wave + tl]; }
        const float r2 = 1.0f / sqrtf(ssq * (1.0f / DM) + NORM_EPS);
        if (pq == 0) R2[t0 + tl] = r2;
        { const f32x4 bq0 = *(const f32x4*)(b_router + 8 * pq), bq1 = *(const f32x4*)(b_router + 8 * pq + 4);
#pragma unroll
          for (int i = 0; i < 4; ++i) { lg[tl * 33 + 8 * pq + i] = s0[i] * r2 + bq0[i]; lg[tl * 33 + 8 * pq + 4 + i] = s1[i] * r2 + bq1[i]; } }
        LDS_WAIT();
        if (lane < 16) {
            float v[32];
#pragma unroll
            for (int e = 0; e < 32; ++e) v[e] = lg[lane * 33 + e];
            int idx[4]; float val[4];
#pragma unroll
            for (int k = 0; k < 4; ++k) {
                float best = -3.0e38f; int bi = 0;
#pragma unroll
                for (int e = 0; e < 32; ++e) { const bool tk = v[e] > best; best = tk ? v[e] : best; bi = tk ? e : bi; }
                idx[k] = bi; val[k] = best;
#pragma unroll
                for (int e = 0; e < 32; ++e) v[e] = (e == bi) ? -3.0e38f : v[e];
            }
            float ex[4], sm = 0.f;
#pragma unroll
            for (int k = 0; k < 4; ++k) { ex[k] = __expf(val[k] - val[0]); sm += ex[k]; }
            const float isum = 1.0f / sm;
#pragma unroll
            for (int k = 0; k < 4; ++k) { selE[lane * 4 + k] = idx[k]; selG[lane * 4 + k] = ex[k] * isum; }
        }
        LDS_WAIT();
        __syncthreads();
        const int myE = selE[lane]; const float myG = selG[lane];
        const int lrank = __hip_atomic_fetch_add(hist + myE, 1, __ATOMIC_RELAXED, __HIP_MEMORY_SCOPE_WORKGROUP);
        __syncthreads();
        if (tid < 32) basee[tid] = (int)__hip_atomic_fetch_add((unsigned*)(ctl + CW_CNT + 64 * tid), (unsigned)hist[tid], RLX_AGENT);
        __syncthreads();
        const int pos = basee[myE] + lrank, pair = (t0 + (lane >> 2)) * 4 + (lane & 3);
        const float myR = r2;
        LISTR[(size_t)myE * T + pos] = (u32x2){(unsigned)pair, __float_as_uint(myR)}; LISTG[(size_t)myE * T + pos] = (u32x2){(unsigned)pair, __float_as_uint(myG)};
        __syncthreads();
    }
    if (!(F.vcu & 1)) { __syncthreads(); convert_experts((const LAS float*)(F.lds + GTAB_OFF), F.lds + RING_OFF, fresh_tid() & 63, wave, F.vcu, F.G); }
    xcd_barrier(bar);

    {
        LAS int* ts = (LAS int*)(F.lds + TS_OFF); LAS int* cn = (LAS int*)(F.lds + CNT_OFF);
        if (threadIdx.x < NE) cn[threadIdx.x] = (int)__hip_atomic_load(ctl + CW_CNT + 64 * threadIdx.x, RLX_AGENT);
        __syncthreads();
        if (threadIdx.x == 0) { int acc = 0; for (int e = 0; e < NE; ++e) { ts[e] = acc; acc += (cn[e] + 255) >> 8; } ts[NE] = acc; }
        __syncthreads();
    }
    const int nMt = __builtin_amdgcn_readfirstlane(((LAS int*)(F.lds + TS_OFF))[NE]);

    for (int rep = 0; rep < REPS(6); ++rep) {
        const KArgs ka = kargs();
        pg8::MoeSched<true> S{KWS(const char, WS_H), KWS(const char, WS_WGU), KWS(const u32x2, WS_LISTR), (LAS const int*)(F.lds + TS_OFF), (LAS const int*)(F.lds + CNT_OFF), 2 * DFF / 256, nMt, F.G, (int)blockIdx.x, (LAS const int*)(F.lds + GTAB_OFF)};
        if (threadIdx.x < 32) S.build_table((LAS int*)(F.lds + GTAB_OFF), (int)threadIdx.x);
        __syncthreads();
        pg8::EpiGateUp E{KWS(unsigned char, WS_ACT), KIN(14)};
        pg8::gemm_phase<pg8::EpiGateUp, pg8::MoeSched<true>>(F.lds + RING_OFF, S, E);
    }
    xcd_barrier(bar);

    for (int rep = 0; rep < REPS(7); ++rep) {
        const KArgs ka = kargs();
        pg8::MoeSched<false> S{KWS(const char, WS_ACT), KWS(const char, WS_WD), KWS(const u32x2, WS_LISTG), (LAS const int*)(F.lds + TS_OFF), (LAS const int*)(F.lds + CNT_OFF), DM / 256, nMt, F.G, (int)blockIdx.x, (LAS const int*)(F.lds + GTAB_OFF + 1024)};
        if (threadIdx.x < 32) S.build_table((LAS int*)(F.lds + GTAB_OFF + 1024), (int)threadIdx.x);
        __syncthreads();
        pg8::EpiDown E{KWS(unsigned char, WS_CONTRIB), KIN(16)};
        pg8::gemm_phase<pg8::EpiDown, pg8::MoeSched<false>>(F.lds + RING_OFF, S, E);
    }
    xcd_barrier(bar);

    {
        const bool bad = (__hip_atomic_load((gu32*)(ctl + CW_BAR) + XB_TMO, RLX_AGENT) != 0u);
        const int lane = fresh_tid() & 63;
        const KArgs ka = kargs();
        const float* const normf_g = KIN(17); const bf16_t* const HB = KWS(bf16_t, WS_HB); const unsigned char* const CONTRIB = KWS(unsigned char, WS_CONTRIB); float* const outp = ka->out;
        f32x4 gn[4];
#pragma unroll
        for (int jh = 0; jh < 2; ++jh) { gn[2 * jh] = *(const f32x4*)(normf_g + jh * 512 + lane * 8); gn[2 * jh + 1] = *(const f32x4*)(normf_g + jh * 512 + lane * 8 + 4); }
        for (int m0 = F.gw; m0 < T; m0 += 2 * F.NGW) {
            u32x4 hw[2][2]; u32x2 cw[2][2][TOPK];
#pragma unroll
            for (int q = 0; q < 2; ++q)
#pragma unroll
                for (int jh = 0; jh < 2; ++jh) { const int m = m0 + q * F.NGW, col = jh * 512 + lane * 8;
                    hw[q][jh] = *(const u32x4*)(HB + (size_t)m * DM + col);
#pragma unroll
                    for (int k = 0; k < TOPK; ++k) cw[q][jh][k] = *(const u32x2*)(CONTRIB + ((size_t)m * TOPK + k) * DM + col); }
#pragma unroll
            for (int q = 0; q < 2; ++q) {
                const int m = m0 + q * F.NGW;
                float v[16];
#pragma unroll
                for (int jh = 0; jh < 2; ++jh) {
                    const u32x4 h4 = hw[q][jh]; float* vv = v + 8 * jh;
                    vv[0] = bf_lo(h4.x); vv[1] = bf_hi(h4.x); vv[2] = bf_lo(h4.y); vv[3] = bf_hi(h4.y); vv[4] = bf_lo(h4.z); vv[5] = bf_hi(h4.z); vv[6] = bf_lo(h4.w); vv[7] = bf_hi(h4.w);
#pragma unroll
                    for (int k = 0; k < TOPK; ++k) { const u32x2 c = cw[q][jh][k];
                        const f32x2 c0 = __builtin_amdgcn_cvt_pk_f32_fp8(c.x, false), c1 = __builtin_amdgcn_cvt_pk_f32_fp8(c.x, true), c2 = __builtin_amdgcn_cvt_pk_f32_fp8(c.y, false), c3 = __builtin_amdgcn_cvt_pk_f32_fp8(c.y, true);
                        vv[0] += c0[0] * 0.0625f; vv[1] += c0[1] * 0.0625f; vv[2] += c1[0] * 0.0625f; vv[3] += c1[1] * 0.0625f; vv[4] += c2[0] * 0.0625f; vv[5] += c2[1] * 0.0625f; vv[6] += c3[0] * 0.0625f; vv[7] += c3[1] * 0.0625f; }
                }
                float sq = 0.f;
#pragma unroll
                for (int k = 0; k < 16; ++k) sq += v[k] * v[k];
                sq = wave_sum(sq);
                float rstd = 1.0f / sqrtf(sq * (1.0f / DM) + NORM_EPS);
                if (bad) rstd = __builtin_nanf("");
#pragma unroll
                for (int jh = 0; jh < 2; ++jh) {
                    const int col = jh * 512 + lane * 8; const float* vv = v + 8 * jh; const f32x4 g0 = gn[2 * jh], g1 = gn[2 * jh + 1];
                    *(f32x4*)(outp + (size_t)m * DM + col) = (f32x4){vv[0] * rstd * g0[0], vv[1] * rstd * g0[1], vv[2] * rstd * g0[2], vv[3] * rstd * g0[3]};
                    *(f32x4*)(outp + (size_t)m * DM + col + 4) = (f32x4){vv[4] * rstd * g1[0], vv[5] * rstd * g1[1], vv[6] * rstd * g1[2], vv[7] * rstd * g1[3]};
                }
            }
        }
    }
}

extern "C" void kernel_launch(void* const* d_in, const int* in_sizes, int n_in, void* d_out, int out_size, void* d_ws, size_t ws_size, hipStream_t stream) {
    static int grid = 0;
    if (grid == 0) {
        if (n_in != 18 || in_sizes[0] != T * DM || out_size != T * DM || ws_size < WS_END) { fprintf(stderr, "kernel_launch: unexpected shapes (n_in %d, ws %zu)\n", n_in, ws_size); grid = -1; return; }
        int dev = 0, cus = 0, per_cu = 0;
        if (hipGetDevice(&dev) != hipSuccess || hipDeviceGetAttribute(&cus, hipDeviceAttributeMultiprocessorCount, dev) != hipSuccess) { grid = -1; return; }
        if (hipFuncSetAttribute((const void*)fwd_kernel, hipFuncAttributeMaxDynamicSharedMemorySize, LDS_BYTES) != hipSuccess) { fprintf(stderr, "kernel_launch: hipFuncSetAttribute failed\n"); grid = -1; return; }
        if (hipOccupancyMaxActiveBlocksPerMultiprocessor(&per_cu, (const void*)fwd_kernel, 512, LDS_BYTES) != hipSuccess || per_cu < 1) { fprintf(stderr, "kernel_launch: occupancy query says %d\n", per_cu); }
        (void)hipGetLastError();
        grid = cus;
    }
    if (grid < 0) return;
    (void)hipMemsetAsync((char*)d_ws + WS_CTL, 0, CTL_ZERO_BYTES, stream);
    Args a{};
    for (int i = 0; i < 18; ++i) a.in[i] = (const float*)d_in[i];
    a.out = (float*)d_out; a.ws = (unsigned char*)d_ws;
    hipLaunchKernelGGL(fwd_kernel, dim3(grid), dim3(512), LDS_BYTES, stream, a);
}
```

```cpp
#include <hip/hip_runtime.h>
#include <cstdio>
#include <cstdint>

#define LAS __attribute__((address_space(3)))
#define GAS __attribute__((address_space(1)))
typedef unsigned short bf16_t;
typedef short bf16x8 __attribute__((ext_vector_type(8)));
typedef short s16x4 __attribute__((ext_vector_type(4)));
typedef float f32x2 __attribute__((ext_vector_type(2)));
typedef float f32x4 __attribute__((ext_vector_type(4)));
typedef float f32x16 __attribute__((ext_vector_type(16)));
typedef unsigned u32x2 __attribute__((ext_vector_type(2)));
typedef unsigned u32x4 __attribute__((ext_vector_type(4)));
typedef GAS unsigned gu32;
typedef int v8i __attribute__((ext_vector_type(8)));

constexpr int BATCH = 16, SEQ = 2048, DM = 1024, T = BATCH * SEQ, HD = 64, NH = 8, AW = 512, INW = 2560;
constexpr int NE = 32, TOPK = 4, DFF = 1024, CHUNK = 128;
constexpr float NORM_EPS = 1e-5f;
constexpr float QSCALE = 0.125f * 1.4426950408889634f;

constexpr size_t MiB = 1u << 20, KiB = 1u << 10;
constexpr size_t WS_CTL = 0, CTL_ZERO_BYTES = 64 * KiB;
constexpr size_t WS_WRT = 1 * MiB, WS_WSB = 1 * MiB + 256 * KiB, WS_COS = 2 * MiB, WS_SIN = 2 * MiB + 256 * KiB;
constexpr size_t WS_R1 = 3 * MiB, WS_R2 = 3 * MiB + 128 * KiB, WS_LSE = 8 * MiB;
constexpr size_t WS_WIN = 16 * MiB, WS_WOUT = 22 * MiB, WS_WGU = 24 * MiB, WS_WD = 152 * MiB, WS_H = 216 * MiB, WS_HB = 344 * MiB;
constexpr size_t WS_ACT = 408 * MiB, WS_XB = 408 * MiB, WS_U = 472 * MiB, WS_VN = 504 * MiB, WS_Q = 536 * MiB, WS_K = 568 * MiB, WS_V = 600 * MiB;
constexpr size_t WS_CONTRIB = 680 * MiB, WS_MIXED = 680 * MiB, WS_BPART = 744 * MiB, WS_LISTR = 936 * MiB, WS_LISTG = 944 * MiB, WS_END = 953 * MiB;
constexpr int CW_TMO = 0, CW_CNT = 8192, CW_BAR = 4096;

constexpr int RING_OFF = 0, RING_BYTES = 131072;
constexpr int LDSCTL_OFF = RING_BYTES;
constexpr int TS_OFF = LDSCTL_OFF, CNT_OFF = LDSCTL_OFF + 256, MISC_OFF = LDSCTL_OFF + 512, HIST_OFF = LDSCTL_OFF + 640, EXCH_OFF = LDSCTL_OFF + 1024, META_OFF = LDSCTL_OFF + 5120;
constexpr int OST_OFF = META_OFF + 6144;
constexpr int GTAB_OFF = OST_OFF + 16384;
constexpr int LDS_BYTES = 163840;
static_assert(EXCH_OFF + 4096 <= META_OFF && GTAB_OFF + 4608 <= LDS_BYTES && 8 * 2816 <= 6144 + 16384, "LDS map");

#define LDS_WAIT() asm volatile("s_waitcnt lgkmcnt(0)" ::: "memory")
#define VM_WAIT() asm volatile("s_waitcnt vmcnt(0)" ::: "memory")
#define RLX_AGENT __ATOMIC_RELAXED, __HIP_MEMORY_SCOPE_AGENT

__device__ __forceinline__ unsigned cvt_pk_bf16(float lo, float hi) { unsigned r; asm volatile("v_cvt_pk_bf16_f32 %0, %1, %2" : "=v"(r) : "v"(lo), "v"(hi)); return r; }
__device__ __forceinline__ unsigned pk4_fp8(float a, float b, float c, float d) { unsigned w = 0; w = __builtin_amdgcn_cvt_pk_fp8_f32(a, b, w, false); w = __builtin_amdgcn_cvt_pk_fp8_f32(c, d, w, true); return w; }
__device__ __forceinline__ float bf_lo(unsigned w) { return __uint_as_float(w << 16); }
__device__ __forceinline__ float bf_hi(unsigned w) { return __uint_as_float(w & 0xffff0000u); }
__device__ __forceinline__ float wave_sum(float v) {
#pragma unroll
    for (int o = 1; o < 64; o <<= 1) v += __shfl_xor(v, o);
    return v;
}
__device__ __forceinline__ float gelu_tanh(float x) {
    const float u = x * (1.0f + 0.044715f * x * x);
    const float e = __builtin_amdgcn_exp2f(-2.3022081981f * u);
    return x * __builtin_amdgcn_rcpf(1.0f + e);
}

__device__ __forceinline__ int fresh_tid() { int t = threadIdx.x; asm volatile("" : "+v"(t)); return t; }
#define XB_TMO      128
#define XB_XCNT(j)  (256  + 64 * (j))
#define XB_XSUB(j)  (1280 + 64 * (j))
#define XB_XGEN(j)  (2304 + 64 * (j))
#define XB_TOP      3328
#define XB_TOPGEN   3392
#define XCD_BAR_WORDS 3456
#define XB_SPIN_CAP (1u << 18)
__device__ __forceinline__ unsigned xb_ld(unsigned* p)              { return __hip_atomic_load(p, __ATOMIC_RELAXED, __HIP_MEMORY_SCOPE_AGENT); }
__device__ __forceinline__ unsigned xb_add(unsigned* p, unsigned v) { return __hip_atomic_fetch_add(p, v, __ATOMIC_RELAXED, __HIP_MEMORY_SCOPE_AGENT); }
__device__ __forceinline__ unsigned xb_xcc_id() { return (unsigned)__builtin_amdgcn_s_getreg((3 << 11) | 20) & 0xFu; }
#define XB_SPIN(cond, bar) do { unsigned _sp = 0; while (cond) { __builtin_amdgcn_s_sleep(1); \
    if ((++_sp & 255u) == 0u) { if (xb_ld(&(bar)[XB_TMO])) break; if (_sp > XB_SPIN_CAP) { atomicAdd(&(bar)[XB_TMO], 1u); break; } } } } while (0)
struct XcdBarrier { unsigned* bar; unsigned x; volatile LAS unsigned* st; };
__device__ __forceinline__ XcdBarrier xcd_barrier_post(unsigned* bar, volatile LAS unsigned* st) {
    XcdBarrier b; b.bar = bar; b.x = xb_xcc_id(); b.st = st;
    if (threadIdx.x == 0) (void)xb_add(&bar[XB_XCNT(b.x)], 1u);
    return b;
}
__device__ __forceinline__ void xcd_barrier_complete(unsigned* bar, unsigned x, unsigned& nloc, unsigned& nx) {
    const unsigned G = gridDim.x * gridDim.y * gridDim.z;
    unsigned sum, cnt, mine, sp = 0u;
    for (;;) {
        sum = 0u; cnt = 0u; mine = 0u;
#pragma unroll
        for (unsigned j = 0; j < 16; ++j) { const unsigned c = xb_ld(&bar[XB_XCNT(j)]); sum += c; cnt += (c > 0u) ? 1u : 0u; mine = (j == x) ? c : mine; }
        if (sum == G) break;
        __builtin_amdgcn_s_sleep(1);
        if ((++sp & 255u) == 0u) { if (xb_ld(&bar[XB_TMO])) break; if (sp > XB_SPIN_CAP) { atomicAdd(&bar[XB_TMO], 1u); break; } }
    }
    nloc = mine > 0u ? mine : 1u; nx = cnt > 0u ? cnt : 1u;
}
__device__ __forceinline__ void xcd_barrier(const XcdBarrier& b) {
    asm volatile("s_waitcnt vmcnt(0)" ::: "memory");
    __syncthreads();
    if (threadIdx.x == 0) {
        unsigned* bar = b.bar;
        const unsigned bx = xb_xcc_id();
        __builtin_amdgcn_s_waitcnt(0);
        unsigned nloc = b.st[0], nx = b.st[1];
        if (nloc == 0u) { xcd_barrier_complete(bar, bx, nloc, nx); b.st[0] = nloc; b.st[1] = nx; }
        const unsigned old = xb_add(&bar[XB_XSUB(bx)], 1u);
        const unsigned gen = old / nloc;
        if (old + 1u == (gen + 1u) * nloc) {
            __builtin_amdgcn_fence(__ATOMIC_RELEASE, "agent");
            asm volatile("s_waitcnt vmcnt(0)" ::: "memory");
            const unsigned og = xb_add(&bar[XB_TOP], 1u);
            const unsigned tg = og / nx;
            if (og + 1u == (tg + 1u) * nx) xb_add(&bar[XB_TOPGEN], 1u);
            else XB_SPIN(xb_ld(&bar[XB_TOPGEN]) == tg, bar);
            __builtin_amdgcn_fence(__ATOMIC_ACQUIRE, "agent");
            xb_add(&bar[XB_XGEN(bx)], 1u);
            asm volatile("s_waitcnt vmcnt(0)" ::: "memory");
        } else {
            XB_SPIN(xb_ld(&bar[XB_XGEN(bx)]) == gen, bar);
            __builtin_amdgcn_fence(__ATOMIC_ACQUIRE, "agent");
            asm volatile("s_waitcnt vmcnt(0)" ::: "memory");
        }
    }
    __syncthreads();
}

__device__ __forceinline__ size_t kv_off(int b, int head, int t) { return ((size_t)((b * NH + head) * SEQ + ((t & 15) << 7) + (t >> 4))) * HD; }
namespace pg8 {
constexpr int BM = 256, BK = 64, HALF = 128, HTB = HALF * BK * 2, NXCD = 8, WGM = 8, KD = 1024;
__device__ __forceinline__ int lds_byte(int r, int c) { const int st = (r >> 4) * 2 + (c >> 5), rr = r & 15, cc = c & 31, ob = rr * 64 + cc * 2; return st * 1024 + (ob ^ (((ob >> 9) & 1) << 5)); }
__device__ __forceinline__ void stage_rc(int b, int& R, int& C) { const int st = b / 1024, sb = b % 1024, swz = sb ^ (((sb >> 9) & 1) << 5); R = (st >> 1) * 16 + swz / 64; C = (st & 1) * 32 + (swz % 64) / 2; }
__device__ __forceinline__ int perm32(int rho) { const int n = rho >> 4, i = rho & 15; return 8 * (i >> 2) + 4 * n + (i & 3); }

struct Unit { int pm, pn, e, lrow0, nvalid; };
typedef int v4i __attribute__((ext_vector_type(4)));
__device__ __forceinline__ v8i ld_frag(const LAS unsigned char* p) { const v4i lo = *(const LAS v4i*)p, hi = *(const LAS v4i*)(p + 1024); return __builtin_shufflevector(lo, hi, 0, 1, 2, 3, 4, 5, 6, 7); }
__device__ __forceinline__ bf16x8 frag_k(const v8i f, int k) { const v4i h = k ? __builtin_shufflevector(f, f, 4, 5, 6, 7) : __builtin_shufflevector(f, f, 0, 1, 2, 3); return __builtin_bit_cast(bf16x8, h); }

__device__ __forceinline__ bool tile_of(int L, int nM, int nN, int& pm, int& pn, const int WGM = 8) {
    const int nwg = nM * nN; if (L >= nwg) return false;
    int wgid = L; { const int q = nwg / NXCD, r = nwg % NXCD, xcd = wgid % NXCD, off = wgid / NXCD; wgid = (xcd < r ? xcd * (q + 1) : r * (q + 1) + (xcd - r) * q) + off; }
    const int nig = WGM * nN, gid = wgid / nig, fm = gid * WGM, gsz = (nM - fm) < WGM ? (nM - fm) : WGM;
    pm = fm + ((wgid % nig) % gsz); pn = (wgid % nig) / gsz; return true;
}
struct DenseSched {
    static constexpr bool HAS_META = false; static constexpr int RB = KD * 2, BMAP = 0, RBB = RB, KSB = BK * 2, KSA = BK * 2;
    const char* A; const char* Bt; int nM, nN, G, c;
    __device__ __forceinline__ const char* meta_src(const Unit&) const { return nullptr; }
    __device__ __forceinline__ const char* bias_src(const Unit&, int) const { return nullptr; }
    __device__ __forceinline__ void a_offs_meta(const Unit& u, const LAS unsigned char*, const int (&R)[2], const int (&C)[2], unsigned (&o)[2][2]) const { a_offs(u, R, C, o); }
    __device__ __forceinline__ bool next(int i, Unit& u) const { u.e = 0; u.lrow0 = 0; u.nvalid = 256; return tile_of(i * G + c, nM, nN, u.pm, u.pn); }
    __device__ __forceinline__ const char* a_base() const { return A; }
    __device__ __forceinline__ void a_offs(const Unit& u, const int (&R)[2], const int (&C)[2], unsigned (&o)[2][2]) const {
#pragma unroll
        for (int h = 0; h < 2; ++h)
#pragma unroll
            for (int i = 0; i < 2; ++i) o[h][i] = (unsigned)((u.pm * BM + h * HALF + R[i]) * KD + C[i]) * 2u;
    }
    __device__ __forceinline__ const char* b_tile(const Unit& u) const { return Bt + (size_t)u.pn * (BM * KD * 2); }
};
template <bool GATHER>
struct MoeSched {
    static constexpr bool HAS_META = true; static constexpr int RB = KD, BMAP = GATHER ? 0 : 1, RBB = 128, KSB = 256 * 128, KSA = GATHER ? BK * 2 : 256 * 128;
    const char* A; const char* Bt; const u32x2* list; LAS const int* ts; LAS const int* cnt; int nN, nM, G, c; LAS const int* utab; const float* bias;
    __device__ __forceinline__ const char* bias_src(const Unit& u, int lane) const {
        return (const char*)(GATHER ? bias + (size_t)u.e * (2 * DFF) + (lane >> 5) * DFF + u.pn * HALF + (lane & 31) * 4 : bias + (size_t)u.e * DM + u.pn * BM + lane * 4); }
    __device__ __forceinline__ bool next(int i, Unit& u) const {
        const v4i q = *(const LAS v4i*)(utab + 8 * i); const int w4 = utab[8 * i + 4];
        u.pm = __builtin_amdgcn_readfirstlane(q[0]); u.pn = __builtin_amdgcn_readfirstlane(q[1]); u.e = __builtin_amdgcn_readfirstlane(q[2]); u.lrow0 = __builtin_amdgcn_readfirstlane(q[3]);
        const int nv = __builtin_amdgcn_readfirstlane(w4); u.nvalid = nv; return nv > 0;
    }
    __device__ __forceinline__ void build_table(LAS int* tab, int t) const {
        Unit u; const bool ok = search(t, u);
        tab[8 * t] = u.pm; tab[8 * t + 1] = u.pn; tab[8 * t + 2] = u.e; tab[8 * t + 3] = u.lrow0; tab[8 * t + 4] = ok ? u.nvalid : 0;
    }
    __device__ __forceinline__ bool search(int i, Unit& u) const {
        u.pm = 0; u.pn = 0; u.e = 0; u.lrow0 = 0; u.nvalid = 0;
        if (!tile_of(i * G + c, nM, nN, u.pm, u.pn, GATHER ? 4 : 8)) return false;
        int e = 0;
#pragma unroll
        for (int s = 16; s >= 1; s >>= 1) { const int v = ts[e + s]; if (v <= u.pm) e += s; }
        const int t0 = ts[e], ce = cnt[e];
        u.e = e; u.lrow0 = (u.pm - t0) * BM; const int rem = ce - u.lrow0; u.nvalid = rem < BM ? rem : BM; return true;
    }
    __device__ __forceinline__ const char* a_base() const { return A; }
    __device__ __forceinline__ const char* meta_src(const Unit& u) const { return (const char*)(list + (size_t)u.e * T + u.lrow0); }
    __device__ __forceinline__ void a_offs(const Unit& u, const int (&R)[2], const int (&C)[2], unsigned (&o)[2][2]) const {
#pragma unroll
        for (int h = 0; h < 2; ++h)
#pragma unroll
            for (int i = 0; i < 2; ++i) {
                if (GATHER) { int lr = h * HALF + R[i]; lr = lr < u.nvalid ? lr : 0; const unsigned v = list[(size_t)u.e * T + u.lrow0 + lr].x; o[h][i] = (unsigned)((int)(v >> 2) * RB + C[i] * 2); }
                else o[h][i] = (unsigned)(u.pm * (8 * 32768) + (h * HALF + R[i]) * 128 + C[i] * 2);
            }
    }
    __device__ __forceinline__ void a_offs_meta(const Unit& u, const LAS unsigned char* meta, const int (&R)[2], const int (&C)[2], unsigned (&o)[2][2]) const {
#pragma unroll
        for (int h = 0; h < 2; ++h)
#pragma unroll
            for (int i = 0; i < 2; ++i) {
                if (GATHER) { int lr = h * HALF + R[i]; lr = lr < u.nvalid ? lr : 0; const unsigned v = *(const LAS unsigned*)(meta + lr * 8); o[h][i] = (unsigned)((int)(v >> 2) * RB + C[i] * 2); }
                else o[h][i] = (unsigned)(u.pm * (8 * 32768) + (h * HALF + R[i]) * 128 + C[i] * 2);
            }
    }
    __device__ __forceinline__ const char* b_tile(const Unit& u) const { return Bt + ((size_t)u.e * nN + u.pn) * (size_t)(BM * RB); }
};

template <class Epi, class Sched>
__device__ __forceinline__ void gemm_phase(LAS unsigned char* lds, const Sched& S, const Epi& E) {
    constexpr int RB = Sched::RB, nt = RB / (BK * 2);
    constexpr bool F8 = (RB == KD);
    const int tid = fresh_tid(), wid = __builtin_amdgcn_readfirstlane(tid >> 6), lane = tid & 63, wr = wid >> 2, wc = wid & 3, fr = lane & 15, fq = lane >> 4;
    int R[2], C[2]; unsigned voffB[2];
#pragma unroll
    for (int i = 0; i < 2; ++i) { stage_rc(tid * 16 + i * 8192, R[i], C[i]); const int rho = R[i] & 31;
        const int Rb = Sched::BMAP == 0 ? (R[i] & ~31) + perm32(rho) : 64 * (R[i] >> 5) + 16 * ((rho & 15) >> 2) + 4 * (rho >> 4) + (rho & 3);
        voffB[i] = (unsigned)(Rb * Sched::RBB + C[i] * 2); }
    constexpr size_t kstep = (size_t)Sched::KSA, kstepB = (size_t)Sched::KSB;
    constexpr size_t hstepB = (size_t)(Sched::BMAP == 0 ? HALF : 8) * Sched::RBB;
    const unsigned ldsw = (unsigned)wid * 1024u;
    const int aoff = lds_byte(wr * 64 + fr, fq * 8), boff = lds_byte(wc * 32 + fr, fq * 8);
#define PG8_SA(b, h) (((b) * 2 + (h)) * HTB)
#define PG8_SB(b, h) ((4 + (b) * 2 + (h)) * HTB)
#define PG8_STAGE_B(bufoff, gbase) do { _Pragma("unroll") for (int _i = 0; _i < 2; ++_i) \
        __builtin_amdgcn_global_load_lds((const unsigned*)((const char*)(gbase) + voffB[_i]), (LAS unsigned*)(lds + (bufoff) + ldsw + _i * 8192), 16, 0, 0); } while (0)
#define PG8_STAGE_A(bufoff, kb, off, h) do { _Pragma("unroll") for (int _i = 0; _i < 2; ++_i) \
        __builtin_amdgcn_global_load_lds((const unsigned*)(Ab + (kb) + (off)[h][_i]), (LAS unsigned*)(lds + (bufoff) + ldsw + _i * 8192), 16, 0, 0); } while (0)
#define PG8_LDA(dst, b, h) do { _Pragma("unroll") for (int m = 0; m < 4; ++m) dst[m] = ld_frag(lds + PG8_SA(b, h) + aoff + m * 2048); } while (0)
#define PG8_LDB(dst, b, h) do { _Pragma("unroll") for (int n = 0; n < 2; ++n) dst[n] = ld_frag(lds + PG8_SB(b, h) + boff + n * 2048); } while (0)
#define PG8_MMA(ai, bj, At, Bt) do { __builtin_amdgcn_s_setprio(1); _Pragma("unroll") for (int m = 0; m < 4; ++m) _Pragma("unroll") for (int n = 0; n < 2; ++n) { \
        if constexpr (F8) { acc[ai][bj][m][n] = __builtin_amdgcn_mfma_scale_f32_16x16x128_f8f6f4(Bt[n], At[m], acc[ai][bj][m][n], 0, 0, 0, 0x7F7F7F7F, 0, 0x7F7F7F7F); } \
        else { _Pragma("unroll") for (int k = 0; k < 2; ++k) acc[ai][bj][m][n] = __builtin_amdgcn_mfma_f32_16x16x32_bf16(frag_k(Bt[n], k), frag_k(At[m], k), acc[ai][bj][m][n], 0, 0, 0); } } \
        __builtin_amdgcn_s_setprio(0); } while (0)
#define PG8_META(slot) (lds + (META_OFF - RING_OFF) + (slot) * 2048)
#define PG8_BIAS(slot) (lds + (OST_OFF - RING_OFF) + (slot) * 1024)
#define PG8_META_DMA(slot, src, un) do { if (Sched::HAS_META && wid == 0) { _Pragma("unroll") for (int _i = 0; _i < 2; ++_i) \
        __builtin_amdgcn_global_load_lds((const unsigned*)((const char*)(src) + (unsigned)((fresh_tid() & 63) * 16 + _i * 1024)), (LAS unsigned*)(PG8_META(slot) + _i * 1024), 16, 0, 0); \
        __builtin_amdgcn_global_load_lds((const unsigned*)S.bias_src(un, fresh_tid() & 63), (LAS unsigned*)PG8_BIAS(slot), 16, 0, 0); } } while (0)
#define PG8_WAIT_V(n) asm volatile("s_waitcnt vmcnt(" #n ")" ::: "memory")
#define PG8_WAIT_L(n) asm volatile("s_waitcnt lgkmcnt(" #n ")" ::: "memory")
#define PG8_BAR __builtin_amdgcn_s_barrier()
#define PG8_SCHED __builtin_amdgcn_sched_barrier(0)
    Unit cur, nxt; int ui = 0, sc = 0;
    if (!S.next(0, cur)) return;
    f32x4 acc[2][2][4][2];
#pragma unroll
    for (int a = 0; a < 2; ++a)
#pragma unroll
        for (int b = 0; b < 2; ++b)
#pragma unroll
            for (int m = 0; m < 4; ++m)
#pragma unroll
                for (int n = 0; n < 2; ++n) acc[a][b][m][n] = (f32x4){0.f, 0.f, 0.f, 0.f};
    v8i At[4], B0[2], B1[2];
    unsigned co[2][2];
    S.a_offs(cur, R, C, co);
    const char* const Ab = S.a_base();
    const char* cB = S.b_tile(cur);
    PG8_META_DMA(0, S.meta_src(cur), cur);
    PG8_STAGE_B(PG8_SB(0, 0), cB); PG8_STAGE_B(PG8_SB(0, 1), cB + hstepB); PG8_STAGE_A(PG8_SA(0, 0), 0, co, 0); PG8_STAGE_A(PG8_SA(0, 1), 0, co, 1);
    if (wr == 1) PG8_BAR;
    PG8_WAIT_V(2); PG8_BAR;
    PG8_STAGE_B(PG8_SB(1, 0), cB + kstepB); PG8_STAGE_A(PG8_SA(1, 0), kstep, co, 0); PG8_STAGE_B(PG8_SB(1, 1), cB + hstepB + kstepB);
    PG8_WAIT_V(6); PG8_BAR;
    for (;;) {
        const bool has_next = S.next(ui + 1, nxt);
        const char* nB = cB;
        const int sn = (sc == 2) ? 0 : sc + 1;
        if (has_next) { nB = S.b_tile(nxt); PG8_META_DMA(sn, S.meta_src(nxt), nxt); }
#pragma nounroll
        for (int t = 0; t < nt; t += 2) {
            const bool last = (t == nt - 2);
            const size_t k1 = (size_t)(t + 1) * kstep;
            const size_t k2 = last ? (size_t)0 : (size_t)(t + 2) * kstep; const char* b2 = last ? nB : cB + (size_t)(t + 2) * kstepB;
            const size_t k3 = k2 + kstep; const char* b3 = b2 + kstepB;
            PG8_LDB(B0, 0, 0); PG8_LDB(B1, 0, 1); PG8_SCHED; PG8_LDA(At, 0, 0); PG8_STAGE_A(PG8_SA(1, 1), k1, co, 1);
            PG8_WAIT_V(8); PG8_WAIT_L(0); PG8_BAR; PG8_MMA(0, 0, At, B0); PG8_MMA(0, 1, At, B1); PG8_BAR; PG8_SCHED;
            if (last && has_next) {
                int R2[2], C2[2]; const int t2 = fresh_tid();
#pragma unroll
                for (int i = 0; i < 2; ++i) stage_rc(t2 * 16 + i * 8192, R2[i], C2[i]);
                S.a_offs_meta(nxt, PG8_META(sn), R2, C2, co);
            }
            PG8_LDA(At, 0, 1); PG8_STAGE_B(PG8_SB(0, 0), b2); PG8_STAGE_B(PG8_SB(0, 1), b2 + hstepB); PG8_STAGE_A(PG8_SA(0, 0), k2, co, 0);
            PG8_WAIT_V(8); PG8_WAIT_L(0); PG8_BAR; PG8_MMA(1, 0, At, B0); PG8_MMA(1, 1, At, B1); PG8_BAR; PG8_SCHED;
            PG8_LDB(B0, 1, 0); PG8_LDB(B1, 1, 1); PG8_SCHED; PG8_LDA(At, 1, 0); PG8_STAGE_A(PG8_SA(0, 1), k2, co, 1);
            PG8_WAIT_V(8); PG8_WAIT_L(0); PG8_BAR; PG8_MMA(0, 0, At, B0); PG8_MMA(0, 1, At, B1); PG8_BAR; PG8_SCHED;
            PG8_LDA(At, 1, 1); PG8_STAGE_B(PG8_SB(1, 0), b3); PG8_STAGE_B(PG8_SB(1, 1), b3 + hstepB); PG8_STAGE_A(PG8_SA(1, 0), k3, co, 0);
            PG8_WAIT_V(8); PG8_WAIT_L(0); PG8_BAR; PG8_MMA(1, 0, At, B0); PG8_MMA(1, 1, At, B1); PG8_BAR; PG8_SCHED;
        }
        if (wr == 0) PG8_BAR;
        E(acc, cur, wr, wc, fr, fq, PG8_META(sc), PG8_BIAS(sc));
        if (!has_next) break;
#pragma unroll
        for (int a = 0; a < 2; ++a)
#pragma unroll
            for (int b = 0; b < 2; ++b)
#pragma unroll
                for (int m = 0; m < 4; ++m)
#pragma unroll
                    for (int n = 0; n < 2; ++n) acc[a][b][m][n] = (f32x4){0.f, 0.f, 0.f, 0.f};
        cur = nxt; cB = nB; ++ui; sc = sn;
        if (wr == 1) PG8_BAR;
    }
    PG8_WAIT_V(0);
    PG8_BAR;
#undef PG8_SA
#undef PG8_SB
#undef PG8_STAGE_A
#undef PG8_STAGE_B
#undef PG8_META
#undef PG8_META_DMA
#undef PG8_BIAS
#undef PG8_LDA
#undef PG8_LDB
#undef PG8_MMA
#undef PG8_WAIT_V
#undef PG8_WAIT_L
#undef PG8_BAR
#undef PG8_SCHED
}

__device__ __forceinline__ void store_bf16x8(bf16_t* p, const f32x4 a, const f32x4 b) {
    u32x4 w; w.x = cvt_pk_bf16(a[0], a[1]); w.y = cvt_pk_bf16(a[2], a[3]); w.z = cvt_pk_bf16(b[0], b[1]); w.w = cvt_pk_bf16(b[2], b[3]);
    *(u32x4*)p = w;
}

struct EpiProj {
    bf16_t *U, *VN, *Q, *KK, *V; const float *R1, *cosT, *sinT, *lng, *lnb;
    __device__ __forceinline__ void operator()(const f32x4 (&acc)[2][2][4][2], const Unit& u, int wr, int wc, int fr, int fq, const LAS unsigned char* meta, const LAS unsigned char* biasl) const {
        const int type = u.pn >> 1, head = (u.pn & 1) * 4 + wc, colb = head * HD + 8 * fq;
        const int row0 = u.pm * BM + wr * 64 + fr;
        float rsv[8];
#pragma unroll
        for (int k = 0; k < 8; ++k) rsv[k] = R1[row0 + (k >> 2) * HALF + (k & 3) * 16];
        if (type == 0 || type == 4) {
            bf16_t* const dst = type == 0 ? U : V;
#pragma unroll
            for (int k = 0; k < 8; ++k) { const int ai = k >> 2, m = k & 3; const float rs = rsv[k];
                f32x4 x00 = acc[ai][0][m][0] * rs, x01 = acc[ai][0][m][1] * rs, x10 = acc[ai][1][m][0] * rs, x11 = acc[ai][1][m][1] * rs;
                if (type == 0) {
#pragma unroll
                    for (int j = 0; j < 4; ++j) { x00[j] = gelu_tanh(x00[j]); x01[j] = gelu_tanh(x01[j]); x10[j] = gelu_tanh(x10[j]); x11[j] = gelu_tanh(x11[j]); } }
                const int row = row0 + ai * HALF + m * 16;
                bf16_t* rp = type == 0 ? dst + (size_t)row * AW + colb : dst + kv_off(row >> 11, head, row & (SEQ - 1)) + 8 * fq;
                store_bf16x8(rp, x00, x01); store_bf16x8(rp + 32, x10, x11); }
        } else if (type == 1) {
            const float* gp = lng + colb; const float* bp = lnb + colb;
            const f32x4 lg0 = *(const f32x4*)(gp), lg1 = *(const f32x4*)(gp + 4), lg2 = *(const f32x4*)(gp + 32), lg3 = *(const f32x4*)(gp + 36);
            const f32x4 lb0 = *(const f32x4*)(bp), lb1 = *(const f32x4*)(bp + 4), lb2 = *(const f32x4*)(bp + 32), lb3 = *(const f32x4*)(bp + 36);
#pragma unroll
            for (int k = 0; k < 8; ++k) { const int ai = k >> 2, m = k & 3; const float rs = rsv[k];
                f32x4 x00 = acc[ai][0][m][0] * rs, x01 = acc[ai][0][m][1] * rs, x10 = acc[ai][1][m][0] * rs, x11 = acc[ai][1][m][1] * rs;
#pragma unroll
                for (int j = 0; j < 4; ++j) { x00[j] = gelu_tanh(x00[j]); x01[j] = gelu_tanh(x01[j]); x10[j] = gelu_tanh(x10[j]); x11[j] = gelu_tanh(x11[j]); }
                float sm = 0.f;
#pragma unroll
                for (int j = 0; j < 4; ++j) sm += (x00[j] + x01[j]) + (x10[j] + x11[j]);
                sm += __shfl_xor(sm, 16); sm += __shfl_xor(sm, 32);
                const float mu = sm * (1.0f / 64.0f);
                x00 -= mu; x01 -= mu; x10 -= mu; x11 -= mu;
                float q = 0.f;
#pragma unroll
                for (int j = 0; j < 4; ++j) q += (x00[j] * x00[j] + x01[j] * x01[j]) + (x10[j] * x10[j] + x11[j] * x11[j]);
                q += __shfl_xor(q, 16); q += __shfl_xor(q, 32);
                const float rstd = 1.0f / sqrtf(q * (1.0f / 64.0f) + NORM_EPS);
                x00 = x00 * rstd * lg0 + lb0; x01 = x01 * rstd * lg1 + lb1; x10 = x10 * rstd * lg2 + lb2; x11 = x11 * rstd * lg3 + lb3;
                bf16_t* rp = VN + (size_t)(row0 + ai * HALF + m * 16) * AW + colb;
                store_bf16x8(rp, x00, x01); store_bf16x8(rp + 32, x10, x11); }
        } else {
            bf16_t* const dst = type == 2 ? Q : KK; const float sc = type == 2 ? QSCALE : 1.0f;
#pragma unroll
            for (int kp = 0; kp < 4; ++kp) {
                f32x4 tc0[2], tc1[2], ts0[2], ts1[2];
#pragma unroll
                for (int mm = 0; mm < 2; ++mm) { const int k = 2 * kp + mm, pos = (row0 + (k >> 2) * HALF + (k & 3) * 16) & (SEQ - 1);
                    tc0[mm] = *(const f32x4*)(cosT + pos * 32 + 8 * fq); tc1[mm] = *(const f32x4*)(cosT + pos * 32 + 8 * fq + 4); ts0[mm] = *(const f32x4*)(sinT + pos * 32 + 8 * fq); ts1[mm] = *(const f32x4*)(sinT + pos * 32 + 8 * fq + 4); }
#pragma unroll
                for (int mm = 0; mm < 2; ++mm) { const int k = 2 * kp + mm, ai = k >> 2, m = k & 3; const float rs = rsv[k] * sc;
                    const f32x4 x00 = acc[ai][0][m][0] * rs, x01 = acc[ai][0][m][1] * rs, x10 = acc[ai][1][m][0] * rs, x11 = acc[ai][1][m][1] * rs;
                    const f32x4 o00 = x00 * tc0[mm] - x10 * ts0[mm], o01 = x01 * tc1[mm] - x11 * ts1[mm], o10 = x10 * tc0[mm] + x00 * ts0[mm], o11 = x11 * tc1[mm] + x01 * ts1[mm];
                    const int row = row0 + ai * HALF + m * 16;
                    bf16_t* rp = dst + kv_off(row >> 11, head, row & (SEQ - 1)) + 8 * fq;
                    store_bf16x8(rp, o00, o01); store_bf16x8(rp + 32, o10, o11); }
            }
        }
    }
};
struct EpiOut {
    const bf16_t* x; bf16_t* HB; unsigned char* H8;
    __device__ __forceinline__ void operator()(const f32x4 (&acc)[2][2][4][2], const Unit& u, int wr, int wc, int fr, int fq, const LAS unsigned char* meta, const LAS unsigned char* biasl) const {
        const int row0 = u.pm * BM + wr * 64 + fr, col0 = u.pn * BM + wc * 32 + 8 * fq;
        u32x4 xw[2][4][2];
#pragma unroll
        for (int ai = 0; ai < 2; ++ai)
#pragma unroll
            for (int m = 0; m < 4; ++m)
#pragma unroll
                for (int bj = 0; bj < 2; ++bj) xw[ai][m][bj] = *(const u32x4*)(x + (size_t)(row0 + ai * HALF + m * 16) * DM + col0 + bj * HALF);
#pragma unroll
        for (int ai = 0; ai < 2; ++ai)
#pragma unroll
            for (int m = 0; m < 4; ++m) {
                const size_t off = (size_t)(row0 + ai * HALF + m * 16) * DM + col0;
#pragma unroll
                for (int bj = 0; bj < 2; ++bj) {
                    const u32x4 q = xw[ai][m][bj];
                    const f32x4 h0 = (f32x4){bf_lo(q.x), bf_hi(q.x), bf_lo(q.y), bf_hi(q.y)} + acc[ai][bj][m][0], h1 = (f32x4){bf_lo(q.z), bf_hi(q.z), bf_lo(q.w), bf_hi(q.w)} + acc[ai][bj][m][1];
                    store_bf16x8(HB + off + bj * HALF, h0, h1);
                    u32x2 w8; w8.x = pk4_fp8(h0[0], h0[1], h0[2], h0[3]); w8.y = pk4_fp8(h1[0], h1[1], h1[2], h1[3]);
                    *(u32x2*)(H8 + off + bj * HALF) = w8;
                }
            }
    }
};
struct EpiGateUp {
    unsigned char* ACT; const float* bgu;
    __device__ __forceinline__ void operator()(const f32x4 (&acc)[2][2][4][2], const Unit& u, int wr, int wc, int fr, int fq, const LAS unsigned char* meta, const LAS unsigned char* biasl) const {
        const LAS float* bp = (const LAS float*)biasl + wc * 32 + 8 * fq;
        const f32x4 bg0 = *(const LAS f32x4*)(bp), bg1 = *(const LAS f32x4*)(bp + 4), bu0 = *(const LAS f32x4*)(bp + 128), bu1 = *(const LAS f32x4*)(bp + 132);
#pragma unroll
        for (int ai = 0; ai < 2; ++ai)
#pragma unroll
            for (int m = 0; m < 4; ++m) {
                const int lr = ai * HALF + wr * 64 + m * 16 + fr;
                const float rs = __uint_as_float(*(const LAS unsigned*)(meta + lr * 8 + 4)) * 0.015625f;
                const f32x4 g0 = acc[ai][0][m][0] * rs + bg0, g1 = acc[ai][0][m][1] * rs + bg1, p0 = acc[ai][1][m][0] * rs + bu0, p1 = acc[ai][1][m][1] * rs + bu1;
                f32x2 a[4];
#pragma unroll
                for (int h2 = 0; h2 < 4; ++h2) {
                    const f32x4 gs = h2 < 2 ? g0 : g1, us = h2 < 2 ? p0 : p1;
                    f32x2 g, u2; g.x = fminf(gs[2 * (h2 & 1)], 7.0f); g.y = fminf(gs[2 * (h2 & 1) + 1], 7.0f);
                    u2.x = __builtin_amdgcn_fmed3f(us[2 * (h2 & 1)], -7.0f, 7.0f); u2.y = __builtin_amdgcn_fmed3f(us[2 * (h2 & 1) + 1], -7.0f, 7.0f);
                    const f32x2 t = g * (-2.4554669595f);
                    f32x2 e; e.x = __builtin_amdgcn_exp2f(t.x); e.y = __builtin_amdgcn_exp2f(t.y);
                    const f32x2 d = e + 1.0f;
                    f32x2 r; r.x = __builtin_amdgcn_rcpf(d.x); r.y = __builtin_amdgcn_rcpf(d.y);
                    a[h2] = ((u2 * 4.0f + 4.0f) * g) * r;
                }
                u32x2 w8; w8.x = pk4_fp8(a[0].x, a[0].y, a[1].x, a[1].y); w8.y = pk4_fp8(a[2].x, a[2].y, a[3].x, a[3].y);
                *(u32x2*)(ACT + (size_t)(u.pm * 8 + u.pn) * 32768 + lr * 128 + wc * 32 + 8 * fq) = w8;
            }
    }
};
struct EpiDown {
    unsigned char* CONTRIB; const float* bd;
    __device__ __forceinline__ void operator()(const f32x4 (&acc)[2][2][4][2], const Unit& u, int wr, int wc, int fr, int fq, const LAS unsigned char* meta, const LAS unsigned char* biasl) const {
        const int col0 = u.pn * BM + wc * 64 + 16 * fq;
        const LAS float* bp = (const LAS float*)biasl + wc * 64 + 16 * fq;
        const f32x4 b00 = *(const LAS f32x4*)(bp), b01 = *(const LAS f32x4*)(bp + 4), b10 = *(const LAS f32x4*)(bp + 8), b11 = *(const LAS f32x4*)(bp + 12);
#pragma unroll
        for (int ai = 0; ai < 2; ++ai)
#pragma unroll
            for (int m = 0; m < 4; ++m) {
                const int lr = ai * HALF + wr * 64 + m * 16 + fr;
                const u32x2 rec = *(const LAS u32x2*)(meta + lr * 8);
                const bool valid = lr < u.nvalid;
                const float gt = valid ? __uint_as_float(rec.y) * 16.0f : 0.f;
                const f32x4 y00 = (acc[ai][0][m][0] * 0.00390625f + b00) * gt, y01 = (acc[ai][0][m][1] * 0.00390625f + b01) * gt, y10 = (acc[ai][1][m][0] * 0.00390625f + b10) * gt, y11 = (acc[ai][1][m][1] * 0.00390625f + b11) * gt;
                if (valid) {
                    u32x4 w; w.x = pk4_fp8(y00[0], y00[1], y00[2], y00[3]); w.y = pk4_fp8(y01[0], y01[1], y01[2], y01[3]); w.z = pk4_fp8(y10[0], y10[1], y10[2], y10[3]); w.w = pk4_fp8(y11[0], y11[1], y11[2], y11[3]);
                    *(u32x4*)(CONTRIB + (size_t)rec.x * DM + col0) = w;
                }
            }
    }
};
}

#ifndef PROBE_DUP
#define PROBE_DUP -1
#endif
#define REPS(k) ((PROBE_DUP == (k)) ? 2 : 1)
struct Frame {
    LAS unsigned char* lds; int tid, lane, wave, vcu, G, gw, NGW;
};

template <bool GAIN>
__device__ __forceinline__ void tr_item(const float* W, int N, int k0, int n0, const float* gain, bf16_t* wt_row0, LAS float* scr, int lane) {
    const int kr = lane >> 3, nq = lane & 7;
    f32x4 v[8]; float gk[8];
#pragma unroll
    for (int it = 0; it < 8; ++it) { const int k = k0 + 8 * it + kr; v[it] = *(const f32x4*)(W + (size_t)k * N + n0 + 4 * nq); gk[it] = GAIN ? gain[k] : 1.0f; }
    if (GAIN) {
#pragma unroll
        for (int it = 0; it < 8; ++it) v[it] = v[it] * gk[it];
    }
#pragma unroll
    for (int it = 0; it < 8; ++it) *(LAS f32x4*)(scr + (8 * it + kr) * 32 + ((nq ^ it) << 2)) = v[it];
    LDS_WAIT();
    const int nl = lane >> 3, c = lane & 7;
#pragma unroll
    for (int iter = 0; iter < 4; ++iter) {
        const int n = nl + 8 * iter; const LAS float* s = scr + (8 * c) * 32 + (((n >> 2) ^ c) << 2) + (n & 3);
        u32x4 o; o.x = cvt_pk_bf16(s[0], s[32]); o.y = cvt_pk_bf16(s[64], s[96]); o.z = cvt_pk_bf16(s[128], s[160]); o.w = cvt_pk_bf16(s[192], s[224]);
        *(u32x4*)(wt_row0 + (size_t)n * 1024 + k0 + 8 * c) = o;
    }
    LDS_WAIT();
}

template <bool GAIN>
__device__ __forceinline__ void tr_item_f8(const float* W, int N, int k0, int n0, const float* gain, float scale, unsigned char* wt_row0, LAS float* scr, int lane) {
    const int kr = lane >> 3, nq = lane & 7;
    f32x4 v[8]; float gk[8];
#pragma unroll
    for (int it = 0; it < 8; ++it) { const int k = k0 + 8 * it + kr; v[it] = *(const f32x4*)(W + (size_t)k * N + n0 + 4 * nq); gk[it] = GAIN ? gain[k] * scale : scale; }
#pragma unroll
    for (int it = 0; it < 8; ++it) v[it] = v[it] * gk[it];
#pragma unroll
    for (int it = 0; it < 8; ++it) *(LAS f32x4*)(scr + (8 * it + kr) * 32 + ((nq ^ it) << 2)) = v[it];
    LDS_WAIT();
    const int nl = lane >> 2, c = lane & 3;
#pragma unroll
    for (int iter = 0; iter < 2; ++iter) {
        const int n = nl + 16 * iter; float f[16];
#pragma unroll
        for (int j = 0; j < 16; ++j) { const int k = 16 * c + j; f[j] = scr[k * 32 + (((n >> 2) ^ ((k >> 3) & 7)) << 2) + (n & 3)]; }
        u32x4 o; o.x = pk4_fp8(f[0], f[1], f[2], f[3]); o.y = pk4_fp8(f[4], f[5], f[6], f[7]); o.z = pk4_fp8(f[8], f[9], f[10], f[11]); o.w = pk4_fp8(f[12], f[13], f[14], f[15]);
        *(u32x4*)(wt_row0 + (size_t)n * 1024 + k0 + 16 * c) = o;
    }
    LDS_WAIT();
}

template <bool GAIN>
__device__ __forceinline__ void tr_item_f8w(const float* W, int N, int k0, int n0, const float* gain, float scale, unsigned char* wt_row0, LAS float* scr, int lane) {
    const int kr = lane >> 3, nq = lane & 7;
    f32x4 v[16]; float gk[16];
#pragma unroll
    for (int it = 0; it < 16; ++it) { const int k = k0 + 8 * it + kr; v[it] = *(const f32x4*)(W + (size_t)k * N + n0 + 4 * nq); gk[it] = GAIN ? gain[k] * scale : scale; }
#pragma unroll
    for (int it = 0; it < 16; ++it) *(LAS f32x4*)(scr + (8 * it + kr) * 32 + ((nq ^ (it & 7)) << 2)) = v[it] * gk[it];
    LDS_WAIT();
    const int nl = lane >> 3, c = lane & 7;
#pragma unroll
    for (int iter = 0; iter < 4; ++iter) {
        const int n = nl + 8 * iter; float f[16];
#pragma unroll
        for (int j = 0; j < 16; ++j) { const int k = 16 * c + j; f[j] = scr[k * 32 + (((n >> 2) ^ ((k >> 3) & 7)) << 2) + (n & 3)]; }
        u32x4 o; o.x = pk4_fp8(f[0], f[1], f[2], f[3]); o.y = pk4_fp8(f[4], f[5], f[6], f[7]); o.z = pk4_fp8(f[8], f[9], f[10], f[11]); o.w = pk4_fp8(f[12], f[13], f[14], f[15]);
        *(u32x4*)(wt_row0 + (size_t)n * 1024 + k0 + 16 * c) = o;
    }
    LDS_WAIT();
}

__device__ __forceinline__ s16x4 tr_read_asm(const LAS unsigned char* p) { s16x4 r; asm volatile("ds_read_b64_tr_b16 %0, %1" : "=v"(r) : "v"((unsigned)(uintptr_t)p) : "memory"); return r; }
struct AttCtx { const bf16_t* Q; const bf16_t* KB; const bf16_t* VB; bf16_t* BPART; float* LSE; };
__device__ __forceinline__ void att_decode(int idx, int& n, int& b, int& head, int& dil, int& r, int& q0, int& qb) {
    n = idx >> 11; const int rem = idx & 2047; b = rem >> 7; head = (rem >> 4) & 7; const int j = (rem + (idx >> 8)) & 15, sh = 2 * n;
    dil = 1 << sh; r = j & (dil - 1); qb = j >> sh; q0 = qb * 128;
}
template <int BUFI>
__device__ __forceinline__ void att_issue(LAS unsigned char* lds, const AttCtx& C, int idx, int wave, int lane) {
    int n, b, head, dil, r, q0, qb; att_decode(idx, n, b, head, dil, r, q0, qb);
#pragma unroll
    for (int t = 0; t < 4; ++t) { const int row = 32 * wave + 8 * t + (lane >> 3); int l = q0 - 128 + row; l = l < 0 ? 0 : l;
        const size_t off = kv_off(b, head, l * dil + r) + (((lane & 7) ^ (row & 7)) << 3);
        __builtin_amdgcn_global_load_lds((const unsigned*)(C.KB + off), (LAS unsigned*)(lds + BUFI * 65536 + (32 * wave + 8 * t) * 128), 16, 0, 0);
        __builtin_amdgcn_global_load_lds((const unsigned*)(C.VB + off), (LAS unsigned*)(lds + BUFI * 65536 + 32768 + (32 * wave + 8 * t) * 128), 16, 0, 0); }
}
struct AttNext { unsigned off[4]; int on; };
__device__ __forceinline__ AttNext att_prep(int idx, bool on, int wave, int lane) {
    AttNext x; x.on = on ? 1 : 0;
    int n, b, head, dil, r, q0, qb; att_decode(on ? idx : 0, n, b, head, dil, r, q0, qb);
#pragma unroll
    for (int t = 0; t < 4; ++t) { const int row = 32 * wave + 8 * t + (lane >> 3); int l = q0 - 128 + row; l = l < 0 ? 0 : l;
        x.off[t] = (unsigned)(kv_off(b, head, l * dil + r) + (((lane & 7) ^ (row & 7)) << 3)); }
    return x;
}
template <int BUFI>
__device__ __forceinline__ void att_dma(LAS unsigned char* lds, const AttCtx& C, const AttNext& x, int t, int wave) {
    if (x.on) {
        __builtin_amdgcn_global_load_lds((const unsigned*)(C.KB + x.off[t]), (LAS unsigned*)(lds + BUFI * 65536 + (32 * wave + 8 * t) * 128), 16, 0, 0);
        __builtin_amdgcn_global_load_lds((const unsigned*)(C.VB + x.off[t]), (LAS unsigned*)(lds + BUFI * 65536 + 32768 + (32 * wave + 8 * t) * 128), 16, 0, 0);
    }
}
__device__ __forceinline__ void att_load_q(const AttCtx& C, int unit, int wave, int lane, bf16x8 (&qf)[2]) {
    int n, b, head, dil, r, q0, qb; att_decode(unit, n, b, head, dil, r, q0, qb);
    const int tq = (q0 + 16 * wave + (lane & 15)) * dil + r;
#pragma unroll
    for (int s2 = 0; s2 < 2; ++s2) qf[s2] = *(const bf16x8*)(C.Q + kv_off(b, head, tq) + 32 * s2 + 8 * (lane >> 4));
}
__device__ __forceinline__ float xrow_max(float x) {
    const auto r16 = __builtin_amdgcn_permlane16_swap(__float_as_uint(x), __float_as_uint(x), false, false); x = fmaxf(__uint_as_float(r16[0]), __uint_as_float(r16[1]));
    const auto r32 = __builtin_amdgcn_permlane32_swap(__float_as_uint(x), __float_as_uint(x), false, false); return fmaxf(__uint_as_float(r32[0]), __uint_as_float(r32[1]));
}
__device__ __forceinline__ float xrow_sum(float x) {
    const auto r16 = __builtin_amdgcn_permlane16_swap(__float_as_uint(x), __float_as_uint(x), false, false); x = __uint_as_float(r16[0]) + __uint_as_float(r16[1]);
    const auto r32 = __builtin_amdgcn_permlane32_swap(__float_as_uint(x), __float_as_uint(x), false, false); return __uint_as_float(r32[0]) + __uint_as_float(r32[1]);
}
template <int OFF>
__device__ __forceinline__ s16x4 tr_read_off(unsigned addr) { s16x4 r; asm volatile("ds_read_b64_tr_b16 %0, %1 offset:%2" : "=v"(r) : "v"(addr), "n"(OFF) : "memory"); return r; }
template <int BUFI>
__device__ __forceinline__ float att_unit(LAS unsigned char* lds, const AttCtx& C, int unit, int wave, int lane, const bf16x8 (&qf)[2], const AttNext& nx) {
    const int qi = lane & 15, g = lane >> 4, li = lane & 15;
    int n, b, head, dil, r, q0, qb; att_decode(unit, n, b, head, dil, r, q0, qb);
    const LAS unsigned char* kl = lds + BUFI * 65536; const LAS unsigned char* vl = kl + 32768;
    const int kt0 = (qb == 0) ? (8 - wave) : 0;
    att_dma<BUFI ^ 1>(lds, C, nx, 0, wave);
    f32x4 S[9];
    const LAS unsigned char* kbase = kl + (16 * wave + qi) * 128;
#pragma unroll
    for (int kt = 0; kt < 9; ++kt) {
        f32x4 a = {0.f, 0.f, 0.f, 0.f};
#pragma unroll
        for (int s2 = 0; s2 < 2; ++s2) {
            const bf16x8 kf = *(const LAS bf16x8*)(kbase + kt * 2048 + (((4 * s2 + g) ^ (qi & 7)) << 4));
            a = __builtin_amdgcn_mfma_f32_16x16x32_bf16(kf, qf[s2], a, 0, 0, 0);
        }
#pragma unroll
        for (int v = 0; v < 4; ++v) { const int c = 4 * g + v; bool ok = true; if (kt == 0) ok = c >= qi; if (kt == 8) ok = c <= qi; S[kt][v] = ok ? a[v] : -1e30f; }
    }
    att_dma<BUFI ^ 1>(lds, C, nx, 1, wave);
    float mx = -1e30f;
#pragma unroll
    for (int kt = 0; kt < 9; ++kt) { const float tm = fmaxf(fmaxf(S[kt][0], S[kt][1]), fmaxf(S[kt][2], S[kt][3])); mx = fmaxf(mx, kt >= kt0 ? tm : -1e30f); }
    mx = xrow_max(mx);
    float lsum = 0.f;
#pragma unroll
    for (int kt = 0; kt < 9; ++kt) { const float mk = kt >= kt0 ? mx : 3.0e38f;
#pragma unroll
        for (int v = 0; v < 4; ++v) { const float pv = __builtin_amdgcn_exp2f(S[kt][v] - mk); S[kt][v] = pv; lsum += pv; } }
    lsum = xrow_sum(lsum);
    att_dma<BUFI ^ 1>(lds, C, nx, 2, wave);
    f32x4 o[4];
#pragma unroll
    for (int dt = 0; dt < 4; ++dt) o[dt] = (f32x4){0.f, 0.f, 0.f, 0.f};
    unsigned vb[4];
    { const int row0 = 16 * wave + 4 * g + (li >> 2), pp = li & 3;
#pragma unroll
      for (int dt = 0; dt < 4; ++dt) vb[dt] = (unsigned)(uintptr_t)(vl + row0 * 128 + (((2 * dt + (pp >> 1)) ^ (row0 & 7)) << 4) + 8 * (pp & 1)); }
    s16x4 lo[2][4], hi[2][4];
#define ATT_TR(set, KA, KB) do { _Pragma("unroll") for (int dt = 0; dt < 4; ++dt) { lo[set][dt] = tr_read_off<(KA) * 2048>(vb[dt]); hi[set][dt] = tr_read_off<(KB) * 2048>(vb[dt]); } } while (0)
#define ATT_PV(set, KA, KB, PAIRED, WAITN) do { \
        u32x4 pw; pw.x = cvt_pk_bf16(S[KA][0], S[KA][1]); pw.y = cvt_pk_bf16(S[KA][2], S[KA][3]); \
        if (PAIRED) { pw.z = cvt_pk_bf16(S[KB][0], S[KB][1]); pw.w = cvt_pk_bf16(S[KB][2], S[KB][3]); } else { pw.z = 0u; pw.w = 0u; } \
        const bf16x8 pb = __builtin_bit_cast(bf16x8, pw); \
        asm volatile("s_waitcnt lgkmcnt(" #WAITN ")" : "+v"(lo[set][0]), "+v"(lo[set][1]), "+v"(lo[set][2]), "+v"(lo[set][3]), "+v"(hi[set][0]), "+v"(hi[set][1]), "+v"(hi[set][2]), "+v"(hi[set][3]) :: "memory"); __builtin_amdgcn_sched_barrier(0); \
        _Pragma("unroll") for (int dt = 0; dt < 4; ++dt) { \
            const bf16x8 va = (bf16x8){lo[set][dt][0], lo[set][dt][1], lo[set][dt][2], lo[set][dt][3], hi[set][dt][0], hi[set][dt][1], hi[set][dt][2], hi[set][dt][3]}; \
            o[dt] = __builtin_amdgcn_mfma_f32_16x16x32_bf16(va, pb, o[dt], 0, 0, 0); } } while (0)
    ATT_TR(0, 0, 1);
    ATT_TR(1, 2, 3); ATT_PV(0, 0, 1, true, 8);
    ATT_TR(0, 4, 5); ATT_PV(1, 2, 3, true, 8);
    att_dma<BUFI ^ 1>(lds, C, nx, 3, wave);
    ATT_TR(1, 6, 7); ATT_PV(0, 4, 5, true, 8);
    ATT_TR(0, 8, 8); ATT_PV(1, 6, 7, true, 8);
    ATT_PV(0, 8, 8, false, 0);
#undef ATT_TR
#undef ATT_PV
    const float inv = 1.0f / lsum;
    LAS unsigned char* ost = lds + (OST_OFF - RING_OFF) + wave * 2048;
#pragma unroll
    for (int dt = 0; dt < 4; ++dt) { u32x2 w; w.x = cvt_pk_bf16(o[dt][0] * inv, o[dt][1] * inv); w.y = cvt_pk_bf16(o[dt][2] * inv, o[dt][3] * inv); *(LAS u32x2*)(ost + qi * 128 + 32 * dt + 8 * g) = w; }
    return mx + __builtin_amdgcn_logf(lsum);
}
__device__ __forceinline__ void att_store(LAS unsigned char* lds, const AttCtx& C, int unit, int wave, int lane, float lse) {
    int n, b, head, dil, r, q0, qb; att_decode(unit, n, b, head, dil, r, q0, qb);
    const LAS unsigned char* ost = lds + (OST_OFF - RING_OFF) + wave * 2048;
    LDS_WAIT();
#pragma unroll
    for (int jr = 0; jr < 2; ++jr) {
        const int row = 8 * jr + (lane >> 3), tr = (q0 + 16 * wave + row) * dil + r;
        const u32x4 ov = *(const LAS u32x4*)(ost + row * 128 + (lane & 7) * 16);
        *(u32x4*)(C.BPART + (size_t)n * T * AW + kv_off(b, head, tr) + (lane & 7) * 8) = ov;
    }
    const int tq = (q0 + 16 * wave + (lane & 15)) * dil + r;
    if ((lane >> 4) == 0) C.LSE[(size_t)n * T * NH + kv_off(b, head, tq) / HD] = lse;
    LDS_WAIT();
}

struct Args { const float* in[18]; float* out; unsigned char* ws; };
typedef const __attribute__((address_space(4))) Args* KArgs;
__device__ __forceinline__ KArgs kargs() { KArgs p = (KArgs)__builtin_amdgcn_kernarg_segment_ptr(); asm volatile("" : "+s"(p)); return p; }
#define KIN(k) (ka->in[k])
#define KWS(Tp, off) ((Tp*)(ka->ws + (off)))
constexpr int CV_I_IN = 16 * (INW / 32), CV_I_OUT = 16 * (DM / 32), CV_I_GU = NE * 8 * (2 * DFF / 32), CV_I_D = NE * 8 * (DM / 32), CV_NITEMS = CV_I_IN + CV_I_OUT + CV_I_GU + CV_I_D;
__device__ __forceinline__ void convert_items(LAS float* scr, int lane, int gw, int NGW, int it_begin, int it_end) {
    const KArgs ka = kargs();
    const float* const norm1_g = KIN(1); const float* const w_in = KIN(2); const float* const a_out_g = KIN(7); const float* const b_out_g = KIN(8); const float* const w_out = KIN(9); const float* const norm2_g = KIN(10);
    const float* const w_gate_up = KIN(13); const float* const w_down = KIN(15);
    bf16_t* const WIN = KWS(bf16_t, WS_WIN); bf16_t* const WOUT = KWS(bf16_t, WS_WOUT); unsigned char* const WGU = KWS(unsigned char, WS_WGU); unsigned char* const WD = KWS(unsigned char, WS_WD);
    constexpr int I_IN = CV_I_IN, I_OUT = CV_I_OUT, I_GU = CV_I_GU;
        for (int it = it_begin + gw; it < it_end; it += NGW) {
        int r = it;
        if (r < I_IN) { const int nb = r % (INW / 32), kb = r / (INW / 32), n0 = nb * 32, tile = n0 >> 8, within = n0 & 255, wcc = within >> 6, bj = (within >> 5) & 1;
            tr_item<true>(w_in, INW, kb * 64, n0, norm1_g, WIN + (size_t)(tile * 256 + 128 * bj + 32 * wcc) * 1024, scr, lane); continue; }
        r -= I_IN;
        if (r < I_OUT) { const int nb = r % (DM / 32), kb = r / (DM / 32), n0 = nb * 32, k0 = kb * 64;
            tr_item<true>(w_out, DM, k0, n0, k0 < AW ? a_out_g : b_out_g - AW, WOUT + (size_t)n0 * 1024, scr, lane); continue; }
        r -= I_OUT;
        if (r < I_GU) { const int e = r / (8 * 64), rr = r % (8 * 64), nb = rr % 64, kb = rr / 64, n0 = nb * 32, bj = n0 >> 10, f = n0 & 1023, pn = f >> 7, wcc = (f >> 5) & 3;
            tr_item_f8w<true>(w_gate_up + (size_t)e * 1024 * 2048, 2 * DFF, kb * 128, n0, norm2_g, 64.0f, WGU + ((size_t)e * 2048 + pn * 256 + 128 * bj + 32 * wcc) * 1024, scr, lane); continue; }
        r -= I_GU;
        { const int e = r / (8 * 32), rr = r % (8 * 32), nb = rr % 32, kb = rr / 32, n0 = nb * 32;
            tr_item_f8w<false>(w_down + (size_t)e * 1024 * 1024, DM, kb * 128, n0, nullptr, 64.0f, WD + ((size_t)e * 1024 + n0) * 1024, scr, lane); }
    }
}

struct CvX { const float* src; unsigned char* dst; int N, gb, gu; };
constexpr int CVW_GU = NE * 8 * 8, CVW_D = NE * 8 * 4, CVW_N = CVW_GU + CVW_D;
__device__ __forceinline__ CvX cvx_decode(int r, int wave, const float* w_gate_up, const float* w_down, unsigned char* WGU, unsigned char* WD) {
    CvX d;
    if (r < CVW_GU) { const int e = r >> 6, kb = (r >> 3) & 7, nb = r & 7, k0 = kb * 128 + 16 * wave;
        d.src = w_gate_up + (size_t)e * 1024 * 2048 + (size_t)k0 * 2048 + nb * 256; d.N = 2 * DFF; d.gb = k0; d.gu = 1;
        const int bj = nb >> 2, pn0 = (nb & 3) * 2;
        d.dst = WGU + (size_t)(e * 8 + pn0) * 262144 + kb * 32768 + (128 * bj) * 128; }
    else { const int q = r - CVW_GU, e = q >> 5, kb = (q >> 2) & 7, nb = q & 3, k0 = kb * 128 + 16 * wave;
        d.src = w_down + (size_t)e * 1024 * 1024 + (size_t)k0 * 1024 + nb * 256; d.N = DM; d.gb = 1024; d.gu = 0;
        d.dst = WD + (size_t)(e * 4 + nb) * 262144 + kb * 32768; }
    return d;
}
__device__ __forceinline__ void cvx_load(const CvX& d, int lane, f32x4 (&v)[16]) {
#pragma unroll
    for (int kk = 0; kk < 16; ++kk) v[kk] = __builtin_nontemporal_load((const f32x4*)(d.src + (size_t)kk * d.N + 4 * lane));
}
__device__ __forceinline__ void cvx_process(const CvX& d, const f32x4 (&v)[16], const LAS float* gtab, LAS unsigned char* img, int lane, int wave) {
    float g[16];
#pragma unroll
    for (int kk = 0; kk < 16; ++kk) g[kk] = gtab[d.gb + kk];
#pragma unroll
    for (int i = 0; i < 4; ++i) {
        u32x4 o; const int c = 4 * lane + i;
        o.x = pk4_fp8(v[0][i] * g[0], v[1][i] * g[1], v[2][i] * g[2], v[3][i] * g[3]); o.y = pk4_fp8(v[4][i] * g[4], v[5][i] * g[5], v[6][i] * g[6], v[7][i] * g[7]);
        o.z = pk4_fp8(v[8][i] * g[8], v[9][i] * g[9], v[10][i] * g[10], v[11][i] * g[11]); o.w = pk4_fp8(v[12][i] * g[12], v[13][i] * g[13], v[14][i] * g[14], v[15][i] * g[15]);
        *(LAS u32x4*)(img + c * 128 + ((wave ^ (c & 7)) << 4)) = o;
    }
    LDS_WAIT(); __builtin_amdgcn_s_barrier(); asm volatile("" ::: "memory");
#pragma unroll
    for (int t = 0; t < 4; ++t) {
        const int c = 32 * wave + 8 * t + (lane >> 3), j = lane & 7, rowb = d.gu ? ((c >> 7) * 262144 + (c & 127) * 128) : c * 128;
        const u32x4 o = *(const LAS u32x4*)(img + c * 128 + ((j ^ (c & 7)) << 4));
        *(u32x4*)(d.dst + rowb + 16 * j) = o;
    }
}
__device__ __forceinline__ void convert_experts(const LAS float* gtab, LAS unsigned char* img, int lane, int wave, int vcu, int G) {
    const KArgs ka = kargs();
    const float* const w_gate_up = KIN(13); const float* const w_down = KIN(15); unsigned char* const WGU = KWS(unsigned char, WS_WGU); unsigned char* const WD = KWS(unsigned char, WS_WD);
    constexpr int NI = CVW_N;
    f32x4 va[16], vb[16];
    int it = vcu; if (it >= NI) return;
    CvX da = cvx_decode(it, wave, w_gate_up, w_down, WGU, WD), db; cvx_load(da, lane, va);
    for (;;) {
        int nx = it + G;
        db = cvx_decode(nx < NI ? nx : it, wave, w_gate_up, w_down, WGU, WD); cvx_load(db, lane, vb);
        cvx_process(da, va, gtab, img, lane, wave);
        if (nx >= NI) break;
        it = nx; nx = it + G;
        da = cvx_decode(nx < NI ? nx : it, wave, w_gate_up, w_down, WGU, WD); cvx_load(da, lane, va);
        cvx_process(db, vb, gtab, img + 32768, lane, wave);
        if (nx >= NI) break;
        it = nx;
    }
}

__global__ void __launch_bounds__(512, 2) fwd_kernel(Args args) {
    extern __shared__ __attribute__((aligned(16))) unsigned char lds_raw[];
    Frame F;
    F.lds = (LAS unsigned char*)lds_raw;
    F.tid = 0; F.lane = 0; F.wave = __builtin_amdgcn_readfirstlane((int)threadIdx.x >> 6);
    F.G = gridDim.x; { const int bx = blockIdx.x; F.vcu = (F.G % 8 == 0) ? (bx % 8) * (F.G / 8) + bx / 8 : bx; }
    F.gw = F.vcu * 8 + F.wave; F.NGW = F.G * 8;
    const int wave = F.wave;
    gu32* const ctl = (gu32*)(kargs()->ws + WS_CTL);

    for (int u = threadIdx.x; u < (LDS_BYTES - LDSCTL_OFF) / 4; u += 512) ((LAS unsigned*)(F.lds + LDSCTL_OFF))[u] = 0u;
    __syncthreads();
    XcdBarrier bar = xcd_barrier_post((unsigned*)(ctl + CW_BAR), (volatile LAS unsigned*)(F.lds + MISC_OFF) + 8);

    for (int rep = 0; rep < REPS(0); ++rep) {
        const int tid = fresh_tid(), lane = tid & 63;
        const KArgs ka = kargs();
        const float* const x = KIN(0); const float* const norm1_g = KIN(1); const float* const w_in = KIN(2); const float* const a_w_s = KIN(5);
        const float* const a_out_g = KIN(7); const float* const b_out_g = KIN(8); const float* const w_out = KIN(9); const float* const norm2_g = KIN(10); const float* const w_router = KIN(11);
        const float* const w_gate_up = KIN(13); const float* const w_down = KIN(15);
        bf16_t* const WRH = KWS(bf16_t, WS_WRT); bf16_t* const WRL = KWS(bf16_t, WS_WRT + 64 * KiB); bf16_t* const WSB = KWS(bf16_t, WS_WSB); float* const COS = KWS(float, WS_COS); float* const SIN = KWS(float, WS_SIN); float* const R1 = KWS(float, WS_R1);
        bf16_t* const WIN = KWS(bf16_t, WS_WIN); bf16_t* const WOUT = KWS(bf16_t, WS_WOUT); unsigned char* const WGU = KWS(unsigned char, WS_WGU); unsigned char* const WD = KWS(unsigned char, WS_WD); bf16_t* const XB = KWS(bf16_t, WS_XB);
        LAS float* scr = (LAS float*)(F.lds + RING_OFF + wave * 16384);
        convert_items(scr, lane, F.gw, F.NGW, 0, CV_I_IN + CV_I_OUT);
        for (int m0 = F.gw; m0 < T; m0 += 4 * F.NGW) {
            f32x4 v[4][4];
#pragma unroll
            for (int q = 0; q < 4; ++q) { const f32x4* xr = (const f32x4*)(x + (size_t)(m0 + q * F.NGW) * DM) + lane;
#pragma unroll
                for (int j = 0; j < 4; ++j) v[q][j] = __builtin_nontemporal_load(xr + 64 * j); }
#pragma unroll
            for (int q = 0; q < 4; ++q) {
                const int m = m0 + q * F.NGW; float sq = 0.f;
#pragma unroll
                for (int j = 0; j < 4; ++j) sq += (v[q][j].x * v[q][j].x + v[q][j].y * v[q][j].y) + (v[q][j].z * v[q][j].z + v[q][j].w * v[q][j].w);
                sq = wave_sum(sq);
                u32x2* o8 = (u32x2*)(XB + (size_t)m * DM) + lane;
#pragma unroll
                for (int j = 0; j < 4; ++j) { u32x2 w; w.x = cvt_pk_bf16(v[q][j].x, v[q][j].y); w.y = cvt_pk_bf16(v[q][j].z, v[q][j].w); o8[64 * j] = w; }
                if (lane == 0) R1[m] = 1.0f / sqrtf(sq * (1.0f / DM) + NORM_EPS);
            }
        }
        const int gt = F.vcu * 512 + tid, NGT = F.G * 512;
        for (int i = gt; i < SEQ * 32; i += NGT) {
            const int pos = i >> 5, d = i & 31;
            const float inv = (float)exp2(-(double)(2 * d) * (13.287712379549449 / 64.0));
            const float ang = (float)pos * inv;
            const double a = (double)ang; const double kq = rint(a * 0.15915494309189535); const float rr = (float)(a - kq * 6.283185307179586);
            COS[i] = cosf(rr); SIN[i] = sinf(rr);
        }
        for (int i = gt; i < NH * CHUNK * CHUNK; i += NGT) { const int s = i & 127, t = (i >> 7) & 127; const float w = (s <= t) ? a_w_s[i] : 0.f; WSB[i] = (bf16_t)(cvt_pk_bf16(w, 0.f) & 0xffffu); }
        for (int i = gt; i < NE * DM; i += NGT) {
            const int e = i >> 10, k = i & 1023; const float w = w_router[k * NE + e] * norm2_g[k];
            const unsigned hi = cvt_pk_bf16(w, 0.f) & 0xffffu; const float lo = w - __uint_as_float(hi << 16);
            WRH[i] = (bf16_t)hi; WRL[i] = (bf16_t)(cvt_pk_bf16(lo, 0.f) & 0xffffu); }
    }
    xcd_barrier(bar);

    for (int rep = 0; rep < REPS(1); ++rep) {
        const KArgs ka = kargs();
        pg8::DenseSched S{KWS(const char, WS_XB), KWS(const char, WS_WIN), T / 256, INW / 256, F.G, (int)blockIdx.x};
        pg8::EpiProj E{KWS(bf16_t, WS_U), KWS(bf16_t, WS_VN), KWS(bf16_t, WS_Q), KWS(bf16_t, WS_K), KWS(bf16_t, WS_V), KWS(float, WS_R1), KWS(float, WS_COS), KWS(float, WS_SIN), KIN(3), KIN(4)};
        pg8::gemm_phase<pg8::EpiProj, pg8::DenseSched>(F.lds + RING_OFF, S, E);
    }
    xcd_barrier(bar);

    for (int rep = 0; rep < REPS(2); ++rep)
    for (int unit = F.vcu; unit < BATCH * (SEQ / CHUNK); unit += F.G) {
        const int tid = fresh_tid(), lane = tid & 63; (void)tid;
        const KArgs ka = kargs();
        const float* const a_b_s = KIN(6); const bf16_t* const VN = KWS(bf16_t, WS_VN); const bf16_t* const U = KWS(bf16_t, WS_U); const bf16_t* const WSB = KWS(bf16_t, WS_WSB); bf16_t* const MIXED = KWS(bf16_t, WS_MIXED);
        const int tok0 = unit * CHUNK, h = wave, hh = lane >> 5, g16 = lane >> 4, li = lane & 15;
        LAS unsigned char* vl = F.lds + RING_OFF + wave * 16384;
        {
            const int cc = lane & 7, rb = lane >> 3;
            u32x4 tmp[16];
#pragma unroll
            for (int it = 0; it < 16; ++it) { const int row = rb + 8 * it; tmp[it] = *(const u32x4*)(VN + (size_t)(tok0 + row) * AW + h * HD + cc * 8); }
#pragma unroll
            for (int it = 0; it < 16; ++it) { const int row = rb + 8 * it; *(LAS u32x4*)(vl + row * 128 + ((cc ^ (row & 7)) << 4)) = tmp[it]; }
            LDS_WAIT();
        }
        bf16x8 wsf[10][2];
#pragma unroll
        for (int tb = 0; tb < 4; ++tb)
#pragma unroll
            for (int st = 0; st <= tb; ++st)
#pragma unroll
                for (int s2 = 0; s2 < 2; ++s2) wsf[tb * (tb + 1) / 2 + st][s2] = *(const bf16x8*)(WSB + ((size_t)h * CHUNK + 32 * tb + (lane & 31)) * CHUNK + 32 * st + 16 * s2 + 8 * hh);
        f32x16 araw[4][2];
#pragma unroll
        for (int tb = 0; tb < 4; ++tb) {
            f32x16 g0, g1;
#pragma unroll
            for (int v = 0; v < 16; ++v) { g0[v] = 0.f; g1[v] = 0.f; }
            const int t = 32 * tb + (lane & 31);
#pragma unroll
            for (int st = 0; st <= tb; ++st)
#pragma unroll
                for (int s2 = 0; s2 < 2; ++s2) {
                    const int s0 = 32 * st + 16 * s2;
                    const bf16x8 wb = wsf[tb * (tb + 1) / 2 + st][s2];
                    const int rowa = s0 + 8 * hh + (li >> 2), rowb = rowa + 4, pp = li & 3;
#pragma unroll
                    for (int dt = 0; dt < 2; ++dt) {
                        const int chunk = 4 * dt + 2 * (g16 & 1) + (pp >> 1);
                        const s16x4 lo = __builtin_bit_cast(s16x4, __builtin_amdgcn_ds_read_tr16_b64_v4i16((LAS s16x4*)(vl + rowa * 128 + ((chunk ^ (rowa & 7)) << 4) + 8 * (pp & 1))));
                        const s16x4 hi = __builtin_bit_cast(s16x4, __builtin_amdgcn_ds_read_tr16_b64_v4i16((LAS s16x4*)(vl + rowb * 128 + ((chunk ^ (rowb & 7)) << 4) + 8 * (pp & 1))));
                        const bf16x8 va = (bf16x8){lo[0], lo[1], lo[2], lo[3], hi[0], hi[1], hi[2], hi[3]};
                        if (dt == 0) g0 = __builtin_amdgcn_mfma_f32_32x32x16_bf16(va, wb, g0, 0, 0, 0); else g1 = __builtin_amdgcn_mfma_f32_32x32x16_bf16(va, wb, g1, 0, 0, 0);
                    }
                }
            araw[tb][0] = g0; araw[tb][1] = g1;
        }
        {
            LDS_WAIT();
            const int cc = lane & 7, rb = lane >> 3;
            u32x4 tmp[16];
#pragma unroll
            for (int it = 0; it < 16; ++it) { const int row = rb + 8 * it; tmp[it] = *(const u32x4*)(U + (size_t)(tok0 + row) * AW + h * HD + cc * 8); }
#pragma unroll
            for (int it = 0; it < 16; ++it) { const int row = rb + 8 * it; *(LAS u32x4*)(vl + row * 128 + ((cc ^ (row & 7)) << 4)) = tmp[it]; }
            LDS_WAIT();
        }
#pragma unroll
        for (int tb = 0; tb < 4; ++tb) {
            const int t = 32 * tb + (lane & 31);
            const float bias = a_b_s[h * CHUNK + t];
            float sq = 0.f;
#pragma unroll
            for (int g = 0; g < 4; ++g) {
                const u32x2 u0 = *(const LAS u32x2*)(vl + t * 128 + ((g ^ (t & 7)) << 4) + 8 * hh), u1 = *(const LAS u32x2*)(vl + t * 128 + (((4 + g) ^ (t & 7)) << 4) + 8 * hh);
                const float a0 = bf_lo(u0.x) * (araw[tb][0][4 * g] + bias), a1 = bf_hi(u0.x) * (araw[tb][0][4 * g + 1] + bias), a2 = bf_lo(u0.y) * (araw[tb][0][4 * g + 2] + bias), a3 = bf_hi(u0.y) * (araw[tb][0][4 * g + 3] + bias);
                const float c0 = bf_lo(u1.x) * (araw[tb][1][4 * g] + bias), c1 = bf_hi(u1.x) * (araw[tb][1][4 * g + 1] + bias), c2 = bf_lo(u1.y) * (araw[tb][1][4 * g + 2] + bias), c3 = bf_hi(u1.y) * (araw[tb][1][4 * g + 3] + bias);
                araw[tb][0][4 * g] = a0; araw[tb][0][4 * g + 1] = a1; araw[tb][0][4 * g + 2] = a2; araw[tb][0][4 * g + 3] = a3;
                araw[tb][1][4 * g] = c0; araw[tb][1][4 * g + 1] = c1; araw[tb][1][4 * g + 2] = c2; araw[tb][1][4 * g + 3] = c3;
                sq += (a0 * a0 + a1 * a1) + (a2 * a2 + a3 * a3) + (c0 * c0 + c1 * c1) + (c2 * c2 + c3 * c3);
            }
            sq += __shfl_xor(sq, 32);
            if (lane < 32) ((LAS float*)(F.lds + EXCH_OFF))[h * CHUNK + t] = sq;
        }
        __syncthreads();
#pragma unroll
        for (int tb = 0; tb < 4; ++tb) {
            const int t = 32 * tb + (lane & 31);
            float tot = 0.f;
#pragma unroll
            for (int k = 0; k < NH; ++k) tot += ((LAS float*)(F.lds + EXCH_OFF))[k * CHUNK + t];
            const float rstd = 1.0f / sqrtf(tot * (1.0f / AW) + NORM_EPS);
#pragma unroll
            for (int g = 0; g < 4; ++g) {
                u32x2 w0, w1;
                w0.x = cvt_pk_bf16(araw[tb][0][4 * g] * rstd, araw[tb][0][4 * g + 1] * rstd); w0.y = cvt_pk_bf16(araw[tb][0][4 * g + 2] * rstd, araw[tb][0][4 * g + 3] * rstd);
                w1.x = cvt_pk_bf16(araw[tb][1][4 * g] * rstd, araw[tb][1][4 * g + 1] * rstd); w1.y = cvt_pk_bf16(araw[tb][1][4 * g + 2] * rstd, araw[tb][1][4 * g + 3] * rstd);
                *(LAS u32x2*)(vl + t * 128 + ((g ^ (t & 7)) << 4) + 8 * hh) = w0; *(LAS u32x2*)(vl + t * 128 + (((4 + g) ^ (t & 7)) << 4) + 8 * hh) = w1;
            }
        }
        {
            LDS_WAIT();
            const int cc = lane & 7, rb = lane >> 3;
#pragma unroll
            for (int it = 0; it < 16; ++it) { const int row = rb + 8 * it; const u32x4 o = *(const LAS u32x4*)(vl + row * 128 + ((cc ^ (row & 7)) << 4)); *(u32x4*)(MIXED + (size_t)(tok0 + row) * DM + h * HD + cc * 8) = o; }
        }
        __syncthreads();
    }

    {
        const int tid = fresh_tid(), lane = tid & 63; (void)tid;
        const KArgs ka = kargs();
        const AttCtx C{KWS(bf16_t, WS_Q), KWS(bf16_t, WS_K), KWS(bf16_t, WS_V), KWS(bf16_t, WS_BPART), KWS(float, WS_LSE)};
        constexpr int NUNIT = 3 * 2048;
        LAS unsigned char* const al = F.lds + RING_OFF;
        bf16x8 qa[2], qb2[2];
        if (F.vcu < NUNIT) { att_issue<0>(al, C, F.vcu, wave, lane); att_load_q(C, F.vcu, wave, lane, qa); }
        __syncthreads();
        float lse = 0.f; int prev = -1;
        for (int unit = F.vcu; unit < NUNIT; unit += 2 * F.G) {
            { const bool on = unit + F.G < NUNIT; const AttNext nx = att_prep(unit + F.G, on, wave, lane);
              if (on) att_load_q(C, unit + F.G, wave, lane, qb2);
              if (prev >= 0) att_store(al, C, prev, wave, lane, lse);
              lse = att_unit<0>(al, C, unit, wave, lane, qa, nx); prev = unit; }
            __syncthreads();
            if (unit + F.G < NUNIT) {
                const bool on = unit + 2 * F.G < NUNIT; const AttNext nx = att_prep(unit + 2 * F.G, on, wave, lane);
                if (on) att_load_q(C, unit + 2 * F.G, wave, lane, qa);
                att_store(al, C, prev, wave, lane, lse);
                lse = att_unit<1>(al, C, unit + F.G, wave, lane, qb2, nx); prev = unit + F.G;
                __syncthreads();
            }
        }
        if (prev >= 0) att_store(al, C, prev, wave, lane, lse);
    }
    xcd_barrier(bar);

    for (int rep = 0; rep < REPS(4); ++rep)
    for (int mo = F.gw; mo < T; mo += F.NGW) {
        const int m = (mo & ~(SEQ - 1)) + ((mo & 127) << 4) + ((mo >> 7) & 15);
        const int lane = fresh_tid() & 63;
        const KArgs ka = kargs();
        const bf16_t* const BPART = KWS(bf16_t, WS_BPART); const float* const LSE = KWS(float, WS_LSE); bf16_t* const MIXED = KWS(bf16_t, WS_MIXED);
        const int head = lane >> 3;
        float L[3]; u32x4 ov[3];
#pragma unroll
        for (int n = 0; n < 3; ++n) { const size_t ro = kv_off(m >> 11, head, m & (SEQ - 1)); L[n] = LSE[(size_t)n * T * NH + ro / HD]; ov[n] = *(const u32x4*)(BPART + (size_t)n * T * AW + ro + (lane & 7) * 8); }
        const float mx = fmaxf(L[0], fmaxf(L[1], L[2]));
        float w[3]; w[0] = __builtin_amdgcn_exp2f(L[0] - mx); w[1] = __builtin_amdgcn_exp2f(L[1] - mx); w[2] = __builtin_amdgcn_exp2f(L[2] - mx);
        const float inv = 1.0f / (w[0] + w[1] + w[2]);
        float o[8];
#pragma unroll
        for (int k = 0; k < 8; ++k) o[k] = 0.f;
#pragma unroll
        for (int n = 0; n < 3; ++n) { const float wn = w[n] * inv;
            o[0] += wn * bf_lo(ov[n].x); o[1] += wn * bf_hi(ov[n].x); o[2] += wn * bf_lo(ov[n].y); o[3] += wn * bf_hi(ov[n].y);
            o[4] += wn * bf_lo(ov[n].z); o[5] += wn * bf_hi(ov[n].z); o[6] += wn * bf_lo(ov[n].w); o[7] += wn * bf_hi(ov[n].w); }
        float s = 0.f;
#pragma unroll
        for (int k = 0; k < 8; ++k) s += o[k] * o[k];
        s = wave_sum(s);
        const float rstd = 1.0f / sqrtf(s * (1.0f / AW) + NORM_EPS);
        u32x4 wv; wv.x = cvt_pk_bf16(o[0] * rstd, o[1] * rstd); wv.y = cvt_pk_bf16(o[2] * rstd, o[3] * rstd); wv.z = cvt_pk_bf16(o[4] * rstd, o[5] * rstd); wv.w = cvt_pk_bf16(o[6] * rstd, o[7] * rstd);
        *(u32x4*)(MIXED + (size_t)m * DM + AW + lane * 8) = wv;
    }
    xcd_barrier(bar);

    for (int rep = 0; rep < REPS(5); ++rep) {
        const KArgs ka = kargs();
        pg8::DenseSched S{KWS(const char, WS_MIXED), KWS(const char, WS_WOUT), T / 256, DM / 256, F.G, (int)blockIdx.x};
        pg8::EpiOut E{KWS(const bf16_t, WS_XB), KWS(bf16_t, WS_HB), KWS(unsigned char, WS_H)};
        pg8::gemm_phase<pg8::EpiOut, pg8::DenseSched>(F.lds + RING_OFF, S, E);
    }
    xcd_barrier(bar);

    { const KArgs ka = kargs(); const float* const norm2_g = KIN(10); LAS float* gt = (LAS float*)(F.lds + GTAB_OFF);
      for (int i = fresh_tid(); i < DM + 128; i += 512) gt[i] = i < DM ? norm2_g[i] * 64.0f : 64.0f;
      __syncthreads(); }
    if (F.vcu & 1) { convert_experts((const LAS float*)(F.lds + GTAB_OFF), F.lds + RING_OFF, fresh_tid() & 63, wave, F.vcu, F.G); __syncthreads(); }
    for (int blk = F.vcu; blk < T / 128; blk += F.G) {
        const int tid = fresh_tid(), lane = tid & 63;
        const KArgs ka = kargs();
        const float* const b_router = KIN(12); const bf16_t* const HB = KWS(bf16_t, WS_HB); const bf16_t* const WRH = KWS(bf16_t, WS_WRT); const bf16_t* const WRL = KWS(bf16_t, WS_WRT + 64 * KiB); float* const R2 = KWS(float, WS_R2);
        u32x2* const LISTR = KWS(u32x2, WS_LISTR); u32x2* const LISTG = KWS(u32x2, WS_LISTG);
        const int t0 = blk * 128 + wave * 16, nn = lane & 15, q4 = lane >> 4, kb = 128 * wave;
        LAS float* part = (LAS float*)(F.lds + RING_OFF) + wave * 4096;
        LAS float* ssqp = (LAS float*)(F.lds + EXCH_OFF) + wave * 128;
        LAS float* lg = (LAS float*)(F.lds + META_OFF + wave * 2816);
        LAS int* selE = (LAS int*)(F.lds + META_OFF + wave * 2816 + 2112);
        LAS float* selG = (LAS float*)(F.lds + META_OFF + wave * 2816 + 2368);
        LAS int* hist = (LAS int*)(F.lds + HIST_OFF); LAS int* basee = hist + 32;
        if (tid < 32) hist[tid] = 0;
        bf16x8 a0[4], a1[4], l0[4], l1[4];
#pragma unroll
        for (int s2 = 0; s2 < 4; ++s2) { const int ko = kb + 32 * s2 + 8 * q4;
            a0[s2] = *(const bf16x8*)(WRH + (size_t)nn * DM + ko); a1[s2] = *(const bf16x8*)(WRH + (size_t)(16 + nn) * DM + ko);
            l0[s2] = *(const bf16x8*)(WRL + (size_t)nn * DM + ko); l1[s2] = *(const bf16x8*)(WRL + (size_t)(16 + nn) * DM + ko); }
#pragma unroll
        for (int half = 0; half < 2; ++half) {
            u32x4 hb[4][4];
#pragma unroll
            for (int g = 0; g < 4; ++g)
#pragma unroll
                for (int s2 = 0; s2 < 4; ++s2) hb[g][s2] = *(const u32x4*)(HB + (size_t)(blk * 128 + 16 * (4 * half + g) + nn) * DM + kb + 32 * s2 + 8 * q4);
#pragma unroll
            for (int g = 0; g < 4; ++g) {
                f32x4 acc0 = {0.f, 0.f, 0.f, 0.f}, acc1 = {0.f, 0.f, 0.f, 0.f}; float ssq = 0.f;
#pragma unroll
                for (int s2 = 0; s2 < 4; ++s2) {
                    const u32x4 hw = hb[g][s2]; const bf16x8 hv = __builtin_bit_cast(bf16x8, hw);
                    const float h0 = bf_lo(hw.x), h1 = bf_hi(hw.x), h2 = bf_lo(hw.y), h3 = bf_hi(hw.y), h4 = bf_lo(hw.z), h5 = bf_hi(hw.z), h6 = bf_lo(hw.w), h7 = bf_hi(hw.w);
                    ssq += ((h0 * h0 + h1 * h1) + (h2 * h2 + h3 * h3)) + ((h4 * h4 + h5 * h5) + (h6 * h6 + h7 * h7));
                    acc0 = __builtin_amdgcn_mfma_f32_16x16x32_bf16(a0[s2], hv, acc0, 0, 0, 0); acc1 = __builtin_amdgcn_mfma_f32_16x16x32_bf16(a1[s2], hv, acc1, 0, 0, 0);
                    acc0 = __builtin_amdgcn_mfma_f32_16x16x32_bf16(l0[s2], hv, acc0, 0, 0, 0); acc1 = __builtin_amdgcn_mfma_f32_16x16x32_bf16(l1[s2], hv, acc1, 0, 0, 0);
                }
                ssq += __shfl_xor(ssq, 16); ssq += __shfl_xor(ssq, 32);
                const int tok = 16 * (4 * half + g) + nn;
                *(LAS f32x4*)(part + tok * 32 + 4 * q4) = acc0; *(LAS f32x4*)(part + tok * 32 + 16 + 4 * q4) = acc1;
                if (q4 == 0) ssqp[tok] = ssq;
            }
        }
        LDS_WAIT();
        __syncthreads();
        const int tl = lane >> 2, pq = lane & 3;
        f32x4 s0 = {0.f, 0.f, 0.f, 0.f}, s1 = {0.f, 0.f, 0.f, 0.f}; float ssq = 0.f;
#pragma unroll
        for (int pw = 0; pw < 8; ++pw) { const LAS float* pp = (const LAS float*)(F.lds + RING_OFF) + pw * 4096 + (16 * wave + tl) * 32 + 8 * pq;
            s0 += *(const LAS f32x4*)pp; s1 += *(const LAS f32x4*)(pp + 4); ssq += ((const LAS float*)(F.lds + EXCH_OFF))[pw * 128 + 16 * wave + tl]; }
        const float r2 = 1.0f / sqrtf(ssq * (1.0f / DM) + NORM_EPS);
        if (pq == 0) R2[t0 + tl] = r2;
        { const f32x4 bq0 = *(const f32x4*)(b_router + 8 * pq), bq1 = *(const f32x4*)(b_router + 8 * pq + 4);
#pragma unroll
          for (int i = 0; i < 4; ++i) { lg[tl * 33 + 8 * pq + i] = s0[i] * r2 + bq0[i]; lg[tl * 33 + 8 * pq + 4 + i] = s1[i] * r2 + bq1[i]; } }
        LDS_WAIT();
        if (lane < 16) {
            float v[32];
#pragma unroll
            for (int e = 0; e < 32; ++e) v[e] = lg[lane * 33 + e];
            int idx[4]; float val[4];
#pragma unroll
            for (int k = 0; k < 4; ++k) {
                float best = -3.0e38f; int bi = 0;
#pragma unroll
                for (int e = 0; e < 32; ++e) { const bool tk = v[e] > best; best = tk ? v[e] : best; bi = tk ? e : bi; }
                idx[k] = bi; val[k] = best;
#pragma unroll
                for (int e = 0; e < 32; ++e) v[e] = (e == bi) ? -3.0e38f : v[e];
            }
            float ex[4], sm = 0.f;
#pragma unroll
            for (int k = 0; k < 4; ++k) { ex[k] = __expf(val[k] - val[0]); sm += ex[k]; }
            const float isum = 1.0f / sm;
#pragma unroll
            for (int k = 0; k < 4; ++k) { selE[lane * 4 + k] = idx[k]; selG[lane * 4 + k] = ex[k] * isum; }
        }
        LDS_WAIT();
        __syncthreads();
        const int myE = selE[lane]; const float myG = selG[lane];
        const int lrank = __hip_atomic_fetch_add(hist + myE, 1, __ATOMIC_RELAXED, __HIP_MEMORY_SCOPE_WORKGROUP);
        __syncthreads();
        if (tid < 32) basee[tid] = (int)__hip_atomic_fetch_add((unsigned*)(ctl + CW_CNT + 64 * tid), (unsigned)hist[tid], RLX_AGENT);
        __syncthreads();
        const int pos = basee[myE] + lrank, pair = (t0 + (lane >> 2)) * 4 + (lane & 3);
        const float myR = r2;
        LISTR[(size_t)myE * T + pos] = (u32x2){(unsigned)pair, __float_as_uint(myR)}; LISTG[(size_t)myE * T + pos] = (u32x2){(unsigned)pair, __float_as_uint(myG)};
        __syncthreads();
    }
    if (!(F.vcu & 1)) { __syncthreads(); convert_experts((const LAS float*)(F.lds + GTAB_OFF), F.lds + RING_OFF, fresh_tid() & 63, wave, F.vcu, F.G); }
    xcd_barrier(bar);

    {
        LAS int* ts = (LAS int*)(F.lds + TS_OFF); LAS int* cn = (LAS int*)(F.lds + CNT_OFF);
        if (threadIdx.x < NE) cn[threadIdx.x] = (int)__hip_atomic_load(ctl + CW_CNT + 64 * threadIdx.x, RLX_AGENT);
        __syncthreads();
        if (threadIdx.x == 0) { int acc = 0; for (int e = 0; e < NE; ++e) { ts[e] = acc; acc += (cn[e] + 255) >> 8; } ts[NE] = acc; }
        __syncthreads();
    }
    const int nMt = __builtin_amdgcn_readfirstlane(((LAS int*)(F.lds + TS_OFF))[NE]);

    for (int rep = 0; rep < REPS(6); ++rep) {
        const KArgs ka = kargs();
        pg8::MoeSched<true> S{KWS(const char, WS_H), KWS(const char, WS_WGU), KWS(const u32x2, WS_LISTR), (LAS const int*)(F.lds + TS_OFF), (LAS const int*)(F.lds + CNT_OFF), 2 * DFF / 256, nMt, F.G, (int)blockIdx.x, (LAS const int*)(F.lds + GTAB_OFF), KIN(14)};
        if (threadIdx.x < 32) S.build_table((LAS int*)(F.lds + GTAB_OFF), (int)threadIdx.x);
        __syncthreads();
        pg8::EpiGateUp E{KWS(unsigned char, WS_ACT), KIN(14)};
        pg8::gemm_phase<pg8::EpiGateUp, pg8::MoeSched<true>>(F.lds + RING_OFF, S, E);
    }
    xcd_barrier(bar);

    for (int rep = 0; rep < REPS(7); ++rep) {
        const KArgs ka = kargs();
        pg8::MoeSched<false> S{KWS(const char, WS_ACT), KWS(const char, WS_WD), KWS(const u32x2, WS_LISTG), (LAS const int*)(F.lds + TS_OFF), (LAS const int*)(F.lds + CNT_OFF), DM / 256, nMt, F.G, (int)blockIdx.x, (LAS const int*)(F.lds + GTAB_OFF + 1024), KIN(16)};
        if (threadIdx.x < 32) S.build_table((LAS int*)(F.lds + GTAB_OFF + 1024), (int)threadIdx.x);
        __syncthreads();
        pg8::EpiDown E{KWS(unsigned char, WS_CONTRIB), KIN(16)};
        pg8::gemm_phase<pg8::EpiDown, pg8::MoeSched<false>>(F.lds + RING_OFF, S, E);
    }
    xcd_barrier(bar);

    {
        const bool bad = (__hip_atomic_load((gu32*)(ctl + CW_BAR) + XB_TMO, RLX_AGENT) != 0u);
        const int lane = fresh_tid() & 63;
        const KArgs ka = kargs();
        const float* const normf_g = KIN(17); const bf16_t* const HB = KWS(bf16_t, WS_HB); const unsigned char* const CONTRIB = KWS(unsigned char, WS_CONTRIB); float* const outp = ka->out;
        f32x4 gn[4];
#pragma unroll
        for (int jh = 0; jh < 2; ++jh) { gn[2 * jh] = *(const f32x4*)(normf_g + jh * 512 + lane * 8); gn[2 * jh + 1] = *(const f32x4*)(normf_g + jh * 512 + lane * 8 + 4); }
        for (int m0 = F.gw; m0 < T; m0 += 2 * F.NGW) {
            u32x4 hw[2][2]; u32x2 cw[2][2][TOPK];
#pragma unroll
            for (int q = 0; q < 2; ++q)
#pragma unroll
                for (int jh = 0; jh < 2; ++jh) { const int m = m0 + q * F.NGW, col = jh * 512 + lane * 8;
                    hw[q][jh] = *(const u32x4*)(HB + (size_t)m * DM + col);
#pragma unroll
                    for (int k = 0; k < TOPK; ++k) cw[q][jh][k] = *(const u32x2*)(CONTRIB + ((size_t)m * TOPK + k) * DM + col); }
#pragma unroll
            for (int q = 0; q < 2; ++q) {
                const int m = m0 + q * F.NGW;
                float v[16];
#pragma unroll
                for (int jh = 0; jh < 2; ++jh) {
                    const u32x4 h4 = hw[q][jh]; float* vv = v + 8 * jh;
                    vv[0] = bf_lo(h4.x); vv[1] = bf_hi(h4.x); vv[2] = bf_lo(h4.y); vv[3] = bf_hi(h4.y); vv[4] = bf_lo(h4.z); vv[5] = bf_hi(h4.z); vv[6] = bf_lo(h4.w); vv[7] = bf_hi(h4.w);
#pragma unroll
                    for (int k = 0; k < TOPK; ++k) { const u32x2 c = cw[q][jh][k];
                        const f32x2 c0 = __builtin_amdgcn_cvt_pk_f32_fp8(c.x, false), c1 = __builtin_amdgcn_cvt_pk_f32_fp8(c.x, true), c2 = __builtin_amdgcn_cvt_pk_f32_fp8(c.y, false), c3 = __builtin_amdgcn_cvt_pk_f32_fp8(c.y, true);
                        vv[0] += c0[0] * 0.0625f; vv[1] += c0[1] * 0.0625f; vv[2] += c1[0] * 0.0625f; vv[3] += c1[1] * 0.0625f; vv[4] += c2[0] * 0.0625f; vv[5] += c2[1] * 0.0625f; vv[6] += c3[0] * 0.0625f; vv[7] += c3[1] * 0.0625f; }
                }
                float sq = 0.f;
#pragma unroll
                for (int k = 0; k < 16; ++k) sq += v[k] * v[k];
                sq = wave_sum(sq);
                float rstd = 1.0f / sqrtf(sq * (1.0f / DM) + NORM_EPS);
                if (bad) rstd = __builtin_nanf("");
#pragma unroll
                for (int jh = 0; jh < 2; ++jh) {
                    const int col = jh * 512 + lane * 8; const float* vv = v + 8 * jh; const f32x4 g0 = gn[2 * jh], g1 = gn[2 * jh + 1];
                    *(f32x4*)(outp + (size_t)m * DM + col) = (f32x4){vv[0] * rstd * g0[0], vv[1] * rstd * g0[1], vv[2] * rstd * g0[2], vv[3] * rstd * g0[3]};
                    *(f32x4*)(outp + (size_t)m * DM + col + 4) = (f32x4){vv[4] * rstd * g1[0], vv[5] * rstd * g1[1], vv[6] * rstd * g1[2], vv[7] * rstd * g1[3]};
                }
            }
        }
    }
}

extern "C" void kernel_launch(void* const* d_in, const int* in_sizes, int n_in, void* d_out, int out_size, void* d_ws, size_t ws_size, hipStream_t stream) {
    static int grid = 0;
    if (grid == 0) {
        if (n_in != 18 || in_sizes[0] != T * DM || out_size != T * DM || ws_size < WS_END) { fprintf(stderr, "kernel_launch: unexpected shapes (n_in %d, ws %zu)\n", n_in, ws_size); grid = -1; return; }
        int dev = 0, cus = 0, per_cu = 0;
        if (hipGetDevice(&dev) != hipSuccess || hipDeviceGetAttribute(&cus, hipDeviceAttributeMultiprocessorCount, dev) != hipSuccess) { grid = -1; return; }
        if (hipFuncSetAttribute((const void*)fwd_kernel, hipFuncAttributeMaxDynamicSharedMemorySize, LDS_BYTES) != hipSuccess) { fprintf(stderr, "kernel_launch: hipFuncSetAttribute failed\n"); grid = -1; return; }
        if (hipOccupancyMaxActiveBlocksPerMultiprocessor(&per_cu, (const void*)fwd_kernel, 512, LDS_BYTES) != hipSuccess || per_cu < 1) { fprintf(stderr, "kernel_launch: occupancy query says %d\n", per_cu); }
        (void)hipGetLastError();
        grid = cus;
    }
    if (grid < 0) return;
    (void)hipMemsetAsync((char*)d_ws + WS_CTL, 0, CTL_ZERO_BYTES, stream);
    Args a{};
    for (int i = 0; i < 18; ++i) a.in[i] = (const float*)d_in[i];
    a.out = (float*)d_out; a.ws = (unsigned char*)d_ws;
    hipLaunchKernelGGL(fwd_kernel, dim3(grid), dim3(512), LDS_BYTES, stream, a);
}
```
